# Optimizing an MI355X kernel written in HIP

```python
import math
import jax, jax.numpy as jnp
from jax import lax
import numpy as np

D_MODEL = 1024
BATCH = 8
SEQ = 4096
DEPTH = 1
DEC_BATCH = 1
DEC_SEQ = 16384
PAST_LEN = 128

HEAD_DIM = 64
GRID_W = 64
NA_HEADS = 8
NA_ROWS = 8
NA_COLS = 16
NA_QBLK = 16
NA_KBLK = 32
NA_WIDTH = NA_HEADS * HEAD_DIM
DIL_GROUPS = ((128, 1), (512, 4), (2048, 16))
DIL_HEADS = 8
DIL_WIDTH = DIL_HEADS * HEAD_DIM
ROPE_THETA = 10000.0
EPS = 1e-6
NEG = -1e30
IN_SIZES = ((NA_WIDTH,) * 4
            + (DIL_WIDTH,) * (3 * len(DIL_GROUPS))
            + (DIL_WIDTH,)
            + (D_MODEL, D_MODEL))
D_IN = sum(IN_SIZES)

kernel_name = "hybrid_natten_dilated_encoder"


def _split_points(sizes):
    pts, acc = [], 0
    for s in sizes[:-1]:
        acc += s
        pts.append(acc)
    return pts


def rms_norm(x, g):
    xf = x.astype(jnp.float32)
    y = xf * lax.rsqrt(jnp.mean(xf * xf, axis=-1, keepdims=True) + EPS)
    return (y * g.astype(jnp.float32)).astype(x.dtype)


def rope(x):
    L, dh = x.shape[1], x.shape[-1]
    inv = ROPE_THETA ** (-jnp.arange(0, dh, 2, dtype=jnp.float32) / dh)
    ang = jnp.arange(L, dtype=jnp.float32)[:, None] * inv[None, :]
    cos = jnp.cos(ang)[None, :, None, :]
    sin = jnp.sin(ang)[None, :, None, :]
    xf = x.astype(jnp.float32)
    x1, x2 = xf[..., : dh // 2], xf[..., dh // 2:]
    return jnp.concatenate([x1 * cos - x2 * sin, x2 * cos + x1 * sin], axis=-1).astype(x.dtype)


def neighborhood_attention(q, k, v, rel_bias):
    B, L, H, dh = q.shape
    rows = L // GRID_W
    kr = min(NA_ROWS, rows)
    ncb = GRID_W // NA_QBLK
    r = jnp.arange(rows)
    row_start = jnp.clip(r - kr // 2, 0, rows - kr)
    key_rows = row_start[:, None] + jnp.arange(kr)[None, :]
    qcol = jnp.arange(ncb)[:, None] * NA_QBLK + jnp.arange(NA_QBLK)[None, :]
    kblk_start = jnp.clip(jnp.arange(ncb) * NA_QBLK - NA_COLS // 2, 0, GRID_W - NA_KBLK)
    key_cols = kblk_start[:, None] + jnp.arange(NA_KBLK)[None, :]
    cstart = jnp.clip(qcol - NA_COLS // 2, 0, GRID_W - NA_COLS)
    kc = key_cols[:, None, :]
    col_ok = (kc >= cstart[:, :, None]) & (kc < cstart[:, :, None] + NA_COLS)
    dcol = jnp.clip(kc - qcol[:, :, None], -(NA_COLS - 1), NA_COLS - 1)
    drow = key_rows - r[:, None]
    h_idx = jnp.arange(H)[None, None, None, :, None, None]
    r_idx = (drow + NA_ROWS - 1)[:, None, None, None, :, None]
    c_idx = (dcol + NA_COLS - 1)[None, :, :, None, None, :]
    bias = rel_bias[h_idx, r_idx, c_idx].astype(jnp.float32)
    kg = k.reshape(B, rows, GRID_W, H, dh)
    vg = v.reshape(B, rows, GRID_W, H, dh)
    ridx = key_rows[:, :, None, None]
    cidx = key_cols[None, None, :, :]
    kb = kg[:, ridx, cidx]
    vb = vg[:, ridx, cidx]
    qb = q.reshape(B, rows, ncb, NA_QBLK, H, dh)
    s = jnp.einsum('brnqhd,brknchd->brnqhkc', qb, kb).astype(jnp.float32) / math.sqrt(dh) + bias
    s = jnp.where(col_ok[:, :, None, None, :], s, NEG)
    p = jax.nn.softmax(s.reshape(s.shape[:-2] + (kr * NA_KBLK,)), axis=-1).reshape(s.shape)
    o = jnp.einsum('brnqhkc,brknchd->brnqhd', p.astype(v.dtype), vb)
    return o.reshape(B, L, H, dh)


def band_attention(q, k, v, half):
    Bs, N, H, dh = q.shape
    blk = half
    nb = -(-N // blk)
    n_pad = nb * blk
    qp = jnp.pad(q, ((0, 0), (0, n_pad - N), (0, 0), (0, 0))).reshape(Bs, nb, blk, H, dh)
    pad_kv = ((0, 0), (blk, n_pad - N + blk), (0, 0), (0, 0))
    kp = jnp.pad(k, pad_kv)
    vp = jnp.pad(v, pad_kv)
    idx = jnp.arange(nb)[:, None] * blk + jnp.arange(3 * blk)[None, :]
    kw = kp[:, idx]
    vw = vp[:, idx]
    kpos = idx - blk
    qpos = jnp.arange(nb)[:, None] * blk + jnp.arange(blk)[None, :]
    ok = ((jnp.abs(kpos[:, None, :] - qpos[:, :, None]) <= half)
          & (kpos >= 0)[:, None, :] & (kpos < N)[:, None, :])
    s = jnp.einsum('bnqhd,bnkhd->bnhqk', qp, kw).astype(jnp.float32) / math.sqrt(dh)
    s = jnp.where(ok[:, None], s, NEG)
    m = jnp.max(s, axis=-1, keepdims=True)
    p = jnp.exp(s - m)
    den = jnp.sum(p, axis=-1, keepdims=True)
    o = jnp.einsum('bnhqk,bnkhd->bnqhd', (p / den).astype(v.dtype), vw)
    lse = (m + jnp.log(den))[..., 0].transpose(0, 1, 3, 2)
    return o.reshape(Bs, n_pad, H, dh)[:, :N], lse.reshape(Bs, n_pad, H)[:, :N]


def dilated_attention(q, k, v, window, dil):
    B, L, H, dh = q.shape
    n = L // dil

    def to_sub(t):
        return t.reshape(B, n, dil, H, dh).transpose(0, 2, 1, 3, 4).reshape(B * dil, n, H, dh)

    o, lse = band_attention(to_sub(q), to_sub(k), to_sub(v), (window // dil) // 2)
    o = o.reshape(B, dil, n, H, dh).transpose(0, 2, 1, 3, 4).reshape(B, L, H, dh)
    lse = lse.reshape(B, dil, n, H).transpose(0, 2, 1, 3).reshape(B, L, H)
    return o, lse


def encoder_layer(x, norm_gain, w_in, qn_a, kn_a, rel_bias_a, qn_b, kn_b, w_branch_a, w_branch_b, w_out):
    B, L, _ = x.shape
    h = rms_norm(x, norm_gain)
    proj = jnp.einsum('bld,de->ble', h, w_in)
    parts = jnp.split(proj, _split_points(IN_SIZES), axis=-1)

    def heads(t):
        return t.reshape(B, L, -1, HEAD_DIM)

    q_a = rms_norm(heads(parts[0]), qn_a)
    k_a = rms_norm(heads(parts[1]), kn_a)
    o_a = neighborhood_attention(q_a, k_a, heads(parts[2]), rel_bias_a).reshape(B, L, NA_WIDTH)
    g_a = parts[3]

    outs, lses = [], []
    for gi, (win, dil) in enumerate(DIL_GROUPS):
        base = 4 + 3 * gi
        q = rope(rms_norm(heads(parts[base]), qn_b))
        k = rope(rms_norm(heads(parts[base + 1]), kn_b))
        o, lse = dilated_attention(q, k, heads(parts[base + 2]), win, dil)
        outs.append(o.astype(jnp.float32))
        lses.append(lse)
    wts = jax.nn.softmax(jnp.stack(lses), axis=0)
    o_b = jnp.einsum('gblh,gblhd->blhd', wts, jnp.stack(outs)).astype(x.dtype).reshape(B, L, DIL_WIDTH)
    g_b, m_a, m_b = parts[-3], parts[-2], parts[-1]

    br_a = jnp.einsum('blc,cd->bld', o_a * jax.nn.silu(g_a), w_branch_a)
    br_b = jnp.einsum('blc,cd->bld', o_b * jax.nn.silu(g_b), w_branch_b)
    merged = jax.nn.sigmoid(m_a) * br_a + jax.nn.sigmoid(m_b) * br_b
    return x + jnp.einsum('bld,de->ble', merged, w_out)


def setup_inputs(seed: int = 0) -> dict:
    key = jax.random.key(seed)
    ks = jax.random.split(key, 13)
    f32 = jnp.float32
    nrm = lambda k, shape, scale: jax.random.normal(k, shape, f32) * scale
    return {
        "x_prompt": nrm(ks[0], (BATCH, SEQ, D_MODEL), 1.0),
        "x_sample": nrm(ks[1], (DEC_BATCH, DEC_SEQ, D_MODEL), 1.0),
        "norm_gain": 1.0 + nrm(ks[2], (DEPTH, D_MODEL), 0.05),
        "w_in": nrm(ks[3], (DEPTH, D_MODEL, D_IN), D_MODEL ** -0.5),
        "qn_a": 1.0 + nrm(ks[4], (DEPTH, HEAD_DIM), 0.05),
        "kn_a": 1.0 + nrm(ks[5], (DEPTH, HEAD_DIM), 0.05),
        "rel_bias_a": nrm(ks[6], (DEPTH, NA_HEADS, 2 * NA_ROWS - 1, 2 * NA_COLS - 1), 0.1),
        "qn_b": 1.0 + nrm(ks[7], (DEPTH, HEAD_DIM), 0.05),
        "kn_b": 1.0 + nrm(ks[8], (DEPTH, HEAD_DIM), 0.05),
        "w_branch_a": nrm(ks[9], (DEPTH, NA_WIDTH, D_MODEL), NA_WIDTH ** -0.5),
        "w_branch_b": nrm(ks[10], (DEPTH, DIL_WIDTH, D_MODEL), DIL_WIDTH ** -0.5),
        "w_out": nrm(ks[11], (DEPTH, D_MODEL, D_MODEL), D_MODEL ** -0.5),
    }


def reference(x_prompt, x_sample, norm_gain, w_in, qn_a, kn_a, rel_bias_a, qn_b, kn_b, w_branch_a, w_branch_b, w_out):
    y_prompt = x_prompt
    y_sample = x_sample
    for l in range(DEPTH):
        y_prompt = encoder_layer(y_prompt, norm_gain[l], w_in[l], qn_a[l], kn_a[l], rel_bias_a[l],
                                 qn_b[l], kn_b[l], w_branch_a[l], w_branch_b[l], w_out[l])
        y_sample = encoder_layer(y_sample, norm_gain[l], w_in[l], qn_a[l], kn_a[l], rel_bias_a[l],
                                 qn_b[l], kn_b[l], w_branch_a[l], w_branch_b[l], w_out[l])
    return (y_prompt, y_sample)
```

```cpp
#include <hip/hip_runtime.h>
#include <hip/hip_cooperative_groups.h>
#include <cstdio>
#include <cstdint>
namespace cg = cooperative_groups;

#define LAS __attribute__((address_space(3)))
typedef unsigned short bf16_t;
typedef short bf16x8 __attribute__((ext_vector_type(8)));
typedef float f32x4 __attribute__((ext_vector_type(4)));
typedef float f32x2 __attribute__((ext_vector_type(2)));
typedef unsigned u32x4 __attribute__((ext_vector_type(4)));
typedef unsigned u32x2 __attribute__((ext_vector_type(2)));

constexpr int DM = 1024, DIN = 9216, T_ALL = 49152, RT = 16384, NROUND = 3, NHEAD = 8;
constexpr int NTHREADS = 512, NWAVES = 8;
constexpr float QSCALE = 0.125f * 1.4426950408889634f;
constexpr float LOG2E = 1.4426950408889634f;

constexpr size_t MiB = 1u << 20;
constexpr size_t WS_WIN = 0;
constexpr size_t WS_WA = 18 * MiB;
constexpr size_t WS_WB = 19 * MiB;
constexpr size_t WS_WO = 20 * MiB;
constexpr size_t WS_ROPE = 22 * MiB;
constexpr size_t WS_H = 26 * MiB;
constexpr size_t WS_HL = 122 * MiB;
constexpr size_t HL_BYTES = 16 * MiB;
constexpr size_t WS_SGA = WS_HL + 12 * HL_BYTES;
constexpr size_t WS_SGB = WS_SGA + 16 * MiB;
constexpr size_t WS_SMA = WS_SGB + 16 * MiB;
constexpr size_t WS_SMB = WS_SMA + 32 * MiB;
constexpr size_t WS_OA = WS_SMB + 32 * MiB;
constexpr size_t WS_OB = WS_OA + 16 * MiB;
constexpr size_t WS_GAINS = WS_OB + 16 * MiB;
constexpr size_t WS_BAR = WS_GAINS + 65536;
constexpr size_t WS_MERGED = WS_GAINS + 1 * MiB;
constexpr size_t WS_END = WS_MERGED + 32 * MiB;
constexpr size_t WS_P = WS_HL + 2 * HL_BYTES;
static_assert(WS_END <= 512 * MiB, "ws map");

__constant__ float INV_FREQ[32] = {1.000000000e+00f, 7.498942018e-01f, 5.623413324e-01f, 4.216965139e-01f, 3.162277639e-01f, 2.371373773e-01f, 1.778279394e-01f, 1.333521456e-01f, 1.000000015e-01f, 7.498942316e-02f, 5.623413250e-02f, 4.216964915e-02f, 3.162277490e-02f, 2.371373773e-02f, 1.778279431e-02f, 1.333521400e-02f, 9.999999776e-03f, 7.498942316e-03f, 5.623413250e-03f, 4.216964822e-03f, 3.162277630e-03f, 2.371373819e-03f, 1.778279431e-03f, 1.333521446e-03f, 1.000000047e-03f, 7.498941850e-04f, 5.623413017e-04f, 4.216965172e-04f, 3.162277571e-04f, 2.371373703e-04f, 1.778279402e-04f, 1.333521504e-04f};

typedef __bf16 bf16x2_hw __attribute__((ext_vector_type(2)));
__device__ __forceinline__ unsigned cvt_pk_bf16(float lo, float hi) { const f32x2 v = {lo, hi}; const bf16x2_hw b = __builtin_convertvector(v, bf16x2_hw); return __builtin_bit_cast(unsigned, b); }
__device__ __forceinline__ float bf_lo(unsigned u) { return __uint_as_float(u << 16); }
__device__ __forceinline__ float bf_hi(unsigned u) { return __uint_as_float(u & 0xffff0000u); }
__device__ __forceinline__ float bf2f(bf16_t u) { return __uint_as_float(((unsigned)u) << 16); }
__device__ __forceinline__ float fast_exp2(float x) { return __builtin_amdgcn_exp2f(x); }
__device__ __forceinline__ float sigmoidf_(float x) { return __builtin_amdgcn_rcpf(1.0f + __builtin_amdgcn_exp2f(x * -1.4426950408889634f)); }
__device__ __forceinline__ float xsum16(float x) { const auto r = __builtin_amdgcn_permlane16_swap(__float_as_uint(x), __float_as_uint(x), false, false); return __uint_as_float(r[0]) + __uint_as_float(r[1]); }
__device__ __forceinline__ float xsum32(float x) { const auto r = __builtin_amdgcn_permlane32_swap(__float_as_uint(x), __float_as_uint(x), false, false); return __uint_as_float(r[0]) + __uint_as_float(r[1]); }
__device__ __forceinline__ float xmax16(float x) { const auto r = __builtin_amdgcn_permlane16_swap(__float_as_uint(x), __float_as_uint(x), false, false); return fmaxf(__uint_as_float(r[0]), __uint_as_float(r[1])); }
__device__ __forceinline__ float xmax32(float x) { const auto r = __builtin_amdgcn_permlane32_swap(__float_as_uint(x), __float_as_uint(x), false, false); return fmaxf(__uint_as_float(r[0]), __uint_as_float(r[1])); }
__device__ __forceinline__ int opaque_tid() { int t = threadIdx.x; asm volatile("" : "+v"(t)); return t; }
__device__ __forceinline__ float wave_sum(float v) {
#pragma unroll
    for (int o = 1; o < 64; o <<= 1) v += __shfl_xor(v, o);
    return v;
}

namespace pg8 {
constexpr int BM = 256, BK = 64, HALF = 128, HTB = HALF * BK * 2, STAGE_BYTES = 8 * HTB, NXCD = 8, WGM = 8;
__host__ __device__ __forceinline__ int lds_byte(int r, int c) { const int st = (r >> 4) * 2 + (c >> 5), rr = r & 15, cc = c & 31, ob = rr * 64 + cc * 2; return st * 1024 + (ob ^ (((ob >> 9) & 1) << 5)); }
__host__ __device__ __forceinline__ void stage_rc(int b, int& R, int& C) { const int st = b / 1024, sb = b % 1024, swz = sb ^ (((sb >> 9) & 1) << 5); R = (st >> 1) * 16 + swz / 64; C = (st & 1) * 32 + (swz % 64) / 2; }
__host__ __device__ __forceinline__ int perm32(int rho) { const int n = rho >> 4, i = rho & 15; return 8 * (i >> 2) + 4 * n + (i & 3); }

struct Unit { int pm, pn, br; };

__device__ __forceinline__ void tile_of(int L, int nM, int nN, int& pm, int& pn) {
    const int nwg = nM * nN; int wgid = L;
    { const int q = nwg / NXCD, r = nwg % NXCD, xcd = wgid % NXCD, off = wgid / NXCD; wgid = (xcd < r ? xcd * (q + 1) : r * (q + 1) + (xcd - r) * q) + off; }
    const int nig = WGM * nN, gid = wgid / nig, fm = gid * WGM, gsz = (nM - fm) < WGM ? (nM - fm) : WGM;
    pm = fm + ((wgid % nig) % gsz); pn = (wgid % nig) / gsz;
}

template <int K, class Epi, class Sched>
__device__ __forceinline__ void gemm_phase(LAS unsigned char* lds, const Sched& S, const Epi& E) {
    int tid_ = threadIdx.x; asm volatile("" : "+v"(tid_));
    const int tid = tid_, wid = __builtin_amdgcn_readfirstlane(tid >> 6), lane = tid & 63, wr = wid >> 2, wc = wid & 3, fr = lane & 15, fq = lane >> 4;
    const int nt = K / BK;
    unsigned voffA[2], voffB[2];
#pragma unroll
    for (int i = 0; i < 2; ++i) { int R, C; stage_rc(tid * 16 + i * 8192, R, C); const int Rb = 64 * (R >> 5) + perm32(R & 31);
        voffA[i] = (unsigned)(R * K + C) * 2u; voffB[i] = (unsigned)(Rb * K + C) * 2u; }
    const size_t kstep = (size_t)(BK * 2);
    const size_t hstep = (size_t)HALF * K * 2;
    const size_t hstepB = (size_t)32 * K * 2;
    const unsigned ldsw = (unsigned)wid * 1024u;
    const int aoff = lds_byte(wr * 64 + fr, fq * 8), boff = lds_byte(wc * 32 + fr, fq * 8);
#define PG8_SA(b, h) (((b) * 2 + (h)) * HTB)
#define PG8_SB(b, h) ((4 + (b) * 2 + (h)) * HTB)
#define PG8_STAGE(bufoff, gbase, voff) do { _Pragma("unroll") for (int _i = 0; _i < 2; ++_i) \
        __builtin_amdgcn_global_load_lds((const unsigned*)((const char*)(gbase) + (voff)[_i]), (LAS unsigned*)(lds + (bufoff) + ldsw + _i * 8192), 16, 0, 0); } while (0)
#define PG8_LDA(dst, b, h) do { _Pragma("unroll") for (int m = 0; m < 4; ++m) _Pragma("unroll") for (int k = 0; k < 2; ++k) dst[m][k] = *(const LAS bf16x8*)(lds + PG8_SA(b, h) + aoff + m * 2048 + k * 1024); } while (0)
#define PG8_LDB(dst, b, h) do { _Pragma("unroll") for (int n = 0; n < 2; ++n) _Pragma("unroll") for (int k = 0; k < 2; ++k) dst[n][k] = *(const LAS bf16x8*)(lds + PG8_SB(b, h) + boff + n * 2048 + k * 1024); } while (0)
#define PG8_MMA(ai, bj, At, Bt) do { __builtin_amdgcn_s_setprio(1); _Pragma("unroll") for (int m = 0; m < 4; ++m) _Pragma("unroll") for (int n = 0; n < 2; ++n) _Pragma("unroll") for (int k = 0; k < 2; ++k) \
        acc[ai][bj][m][n] = __builtin_amdgcn_mfma_f32_16x16x32_bf16(Bt[n][k], At[m][k], acc[ai][bj][m][n], 0, 0, 0); __builtin_amdgcn_s_setprio(0); } while (0)
#define PG8_WAIT_V(n) asm volatile("s_waitcnt vmcnt(" #n ")" ::: "memory")
#define PG8_WAIT_L(n) asm volatile("s_waitcnt lgkmcnt(" #n ")" ::: "memory")
#define PG8_BAR __builtin_amdgcn_s_barrier()
#define PG8_SCHED __builtin_amdgcn_sched_barrier(0)
    Unit cur, nxt; int ui = 0;
    if (!S.next(0, cur)) return;
    f32x4 acc[2][2][4][2];
#pragma unroll
    for (int a = 0; a < 2; ++a)
#pragma unroll
        for (int b = 0; b < 2; ++b)
#pragma unroll
            for (int m = 0; m < 4; ++m)
#pragma unroll
                for (int n = 0; n < 2; ++n) acc[a][b][m][n] = (f32x4){0.f, 0.f, 0.f, 0.f};
    bf16x8 At[4][2], B0[2][2], B1[2][2];
    const char* cA = S.a_ptr(cur); const char* cB = S.b_ptr(cur);
    PG8_STAGE(PG8_SB(0, 0), cB, voffB); PG8_STAGE(PG8_SB(0, 1), cB + hstepB, voffB); PG8_STAGE(PG8_SA(0, 0), cA, voffA); PG8_STAGE(PG8_SA(0, 1), cA + hstep, voffA);
    if (wr == 1) PG8_BAR;
    PG8_WAIT_V(2); PG8_BAR;
    PG8_STAGE(PG8_SB(1, 0), cB + kstep, voffB); PG8_STAGE(PG8_SA(1, 0), cA + kstep, voffA); PG8_STAGE(PG8_SB(1, 1), cB + hstepB + kstep, voffB);
    PG8_WAIT_V(6); PG8_BAR;
    for (;;) {
        const bool has_next = S.next(ui + 1, nxt);
        const char* nA = has_next ? S.a_ptr(nxt) : cA; const char* nB = has_next ? S.b_ptr(nxt) : cB;
        for (int t = 0; t < nt; t += 2) {
            const bool last = (t == nt - 2);
            const char* a1 = cA + (size_t)(t + 1) * kstep;
            const char* a2 = last ? nA : cA + (size_t)(t + 2) * kstep; const char* b2 = last ? nB : cB + (size_t)(t + 2) * kstep;
            const char* a3 = a2 + kstep; const char* b3 = b2 + kstep;
            if constexpr (Epi::MIDK) { if (t == nt / 2) { int z_ = t - nt / 2; asm volatile("" : "+v"(z_)); E.mid(acc, cur, wr, wc, fr + z_, fq); } }
            PG8_LDB(B0, 0, 0); PG8_LDB(B1, 0, 1); PG8_SCHED; PG8_LDA(At, 0, 0); PG8_STAGE(PG8_SA(1, 1), a1 + hstep, voffA);
            PG8_WAIT_V(8); PG8_WAIT_L(0); PG8_BAR; PG8_MMA(0, 0, At, B0); PG8_MMA(0, 1, At, B1); PG8_BAR; PG8_SCHED;
            PG8_LDA(At, 0, 1); PG8_STAGE(PG8_SB(0, 0), b2, voffB); PG8_STAGE(PG8_SB(0, 1), b2 + hstepB, voffB); PG8_STAGE(PG8_SA(0, 0), a2, voffA);
            PG8_WAIT_V(8); PG8_WAIT_L(0); PG8_BAR; PG8_MMA(1, 0, At, B0); PG8_MMA(1, 1, At, B1); PG8_BAR; PG8_SCHED;
            PG8_LDB(B0, 1, 0); PG8_LDB(B1, 1, 1); PG8_SCHED; PG8_LDA(At, 1, 0); PG8_STAGE(PG8_SA(0, 1), a2 + hstep, voffA);
            PG8_WAIT_V(8); PG8_WAIT_L(0); PG8_BAR; PG8_MMA(0, 0, At, B0); PG8_MMA(0, 1, At, B1); PG8_BAR; PG8_SCHED;
            PG8_LDA(At, 1, 1); PG8_STAGE(PG8_SB(1, 0), b3, voffB); PG8_STAGE(PG8_SB(1, 1), b3 + hstepB, voffB); PG8_STAGE(PG8_SA(1, 0), a3, voffA);
            PG8_WAIT_V(8); PG8_WAIT_L(0); PG8_BAR; PG8_MMA(1, 0, At, B0); PG8_MMA(1, 1, At, B1); PG8_BAR; PG8_SCHED;
        }
        if (wr == 0) PG8_BAR;
        E.fin(acc, cur, wr, wc, fr, fq);
        if (!has_next) break;
#pragma unroll
        for (int a = 0; a < 2; ++a)
#pragma unroll
            for (int b = 0; b < 2; ++b)
#pragma unroll
                for (int m = 0; m < 4; ++m)
#pragma unroll
                    for (int n = 0; n < 2; ++n) acc[a][b][m][n] = (f32x4){0.f, 0.f, 0.f, 0.f};
        cur = nxt; cA = nA; cB = nB; ++ui;
        if (wr == 1) PG8_BAR;
    }
    PG8_WAIT_V(0);
    PG8_BAR;
#undef PG8_SA
#undef PG8_SB
#undef PG8_STAGE
#undef PG8_LDA
#undef PG8_LDB
#undef PG8_MMA
#undef PG8_WAIT_V
#undef PG8_WAIT_L
#undef PG8_BAR
#undef PG8_SCHED
}
}
using pg8::Unit;

__device__ __forceinline__ int perm_row(int ml, int lgL, int ld) {
    const int L = 1 << lgL, t = ml & (L - 1), sb = ml - t;
    return sb + ((t & ((1 << ld) - 1)) << (lgL - ld)) + (t >> ld);
}

constexpr int EPI_LDS_OFF = 131072 + 256, EPI_SLICE = 16 * 144;
__device__ __forceinline__ void epi_rows(LAS unsigned char* sl, int fr, int fq, const u32x4& w0, const u32x4& w1, u32x4& r0, u32x4& r1) {
    *(LAS u32x4*)(sl + fr * 144 + fq * 16) = w0; *(LAS u32x4*)(sl + fr * 144 + 64 + fq * 16) = w1;
    const int lane = fr + 16 * fq, row = lane >> 3, part = lane & 7;
    r0 = *(const LAS u32x4*)(sl + row * 144 + part * 16); r1 = *(const LAS u32x4*)(sl + (row + 8) * 144 + part * 16);
}

__device__ __forceinline__ void rows_to_lane(LAS unsigned char* sl, int lane, int fr, int a0, int a1, const u32x4& r0, const u32x4& r1, u32x4& p0, u32x4& p1) {
    const int row = lane >> 3, part = lane & 7;
    *(LAS u32x4*)(sl + row * 144 + part * 16) = r0; *(LAS u32x4*)(sl + (row + 8) * 144 + part * 16) = r1;
    p0 = *(const LAS u32x4*)(sl + fr * 144 + a0 * 16); p1 = *(const LAS u32x4*)(sl + fr * 144 + a1 * 16);
}
__device__ __forceinline__ void lane_to_rows(LAS unsigned char* sl, int lane, int fr, int a0, int a1, const u32x4& p0, const u32x4& p1, u32x4& r0, u32x4& r1) {
    const int row = lane >> 3, part = lane & 7;
    *(LAS u32x4*)(sl + fr * 144 + a0 * 16) = p0; *(LAS u32x4*)(sl + fr * 144 + a1 * 16) = p1;
    r0 = *(const LAS u32x4*)(sl + row * 144 + part * 16); r1 = *(const LAS u32x4*)(sl + (row + 8) * 144 + part * 16);
}

struct EpiG1 {
    static constexpr bool MIDK = false;
    unsigned char* ws; int lgL; LAS unsigned char* lds_epi;
    __device__ __forceinline__ void fin(const f32x4 (&acc)[2][2][4][2], const Unit& u, int wr, int wc, int fr, int fq) const {
        const int cb = u.pn >> 1, half = u.pn & 1;
        const int rowb = u.pm * 256 + wr * 64 + fr;
        LAS unsigned char* sl = lds_epi + (wr * 4 + wc) * EPI_SLICE;
        const int lane_ = fr + 16 * fq, srow = lane_ >> 3, spart = lane_ & 7, rowb0 = u.pm * 256 + wr * 64;
        if (cb == 3 || cb >= 13) {
            bf16_t* dst; int ld_, colb; bool sig;
            if (cb == 3) { dst = (bf16_t*)(ws + WS_SGA); ld_ = 512; colb = half * 256; sig = false; }
            else if (cb == 13) { dst = (bf16_t*)(ws + WS_SGB); ld_ = 512; colb = half * 256; sig = false; }
            else if (cb < 16) { dst = (bf16_t*)(ws + WS_SMA); ld_ = 1024; colb = (u.pn - 28) * 256; sig = true; }
            else { dst = (bf16_t*)(ws + WS_SMB); ld_ = 1024; colb = (u.pn - 32) * 256; sig = true; }
#pragma unroll
            for (int ai = 0; ai < 2; ++ai)
#pragma unroll
                for (int m = 0; m < 4; ++m) {
                    float x[16], t[16];
#pragma unroll
                    for (int bj = 0; bj < 2; ++bj)
#pragma unroll
                        for (int n = 0; n < 2; ++n)
#pragma unroll
                            for (int e = 0; e < 4; ++e) x[8 * bj + 4 * n + e] = acc[ai][bj][m][n][e];
#pragma unroll
                    for (int j = 0; j < 16; ++j) t[j] = x[j] * -1.4426950408889634f;
#pragma unroll
                    for (int j = 0; j < 16; ++j) t[j] = __builtin_amdgcn_exp2f(t[j]);
#pragma unroll
                    for (int j = 0; j < 16; ++j) t[j] = 1.0f + t[j];
#pragma unroll
                    for (int j = 0; j < 16; ++j) t[j] = __builtin_amdgcn_rcpf(t[j]);
                    if (!sig) {
#pragma unroll
                        for (int j = 0; j < 16; ++j) t[j] = x[j] * t[j];
                    }
                    u32x4 w[2], r0, r1;
#pragma unroll
                    for (int bj = 0; bj < 2; ++bj) { w[bj].x = cvt_pk_bf16(t[8 * bj + 0], t[8 * bj + 1]); w[bj].y = cvt_pk_bf16(t[8 * bj + 2], t[8 * bj + 3]); w[bj].z = cvt_pk_bf16(t[8 * bj + 4], t[8 * bj + 5]); w[bj].w = cvt_pk_bf16(t[8 * bj + 6], t[8 * bj + 7]); }
                    if (sig) {
                        bf16_t* gp = dst + ((((size_t)(u.pm * 4 + (colb >> 8)) * 8 + (wr * 4 + wc)) * 2 + ai) * 4 + m) * 1024 + lane_ * 8;
                        *(u32x4*)gp = w[0]; *(u32x4*)(gp + 512) = w[1];
                    } else {
                        epi_rows(sl, fr, fq, w[0], w[1], r0, r1);
                        bf16_t* rp0 = dst + (size_t)(rowb0 + ai * 128 + m * 16 + srow) * ld_ + colb + wc * 64 + spart * 8;
                        *(u32x4*)rp0 = r0; *(u32x4*)(rp0 + (size_t)8 * ld_) = r1;
                    }
                }
            return;
        }
        const int hl = cb < 3 ? cb : cb - 1;
        const int typ = cb < 3 ? cb : (cb - 4) % 3;
        const int grp = cb < 3 ? -1 : (cb - 4) / 3;
        const int ld = grp < 0 ? 0 : 2 * grp;
        const int head = 4 * half + wc;
        bf16_t* dst = (bf16_t*)(ws + WS_HL + (size_t)hl * HL_BYTES) + (size_t)head * RT * 64 + 8 * spart;
        float gn[2][8];
        if (typ < 2) {
            const float* g = (const float*)(ws + WS_GAINS) + ((grp < 0 ? 0 : 2) + typ) * 64;
            const float sc = typ == 0 ? QSCALE : 1.0f;
#pragma unroll
            for (int bj = 0; bj < 2; ++bj)
#pragma unroll
                for (int j = 0; j < 8; ++j) gn[bj][j] = g[32 * bj + 8 * fq + j] * sc;
        }
        const float* rope = (const float*)(ws + WS_ROPE);
        const int Lm = (1 << lgL) - 1;
#pragma unroll
        for (int ai = 0; ai < 2; ++ai)
#pragma unroll
            for (int m = 0; m < 4; ++m) {
                const int ml = rowb + ai * 128 + m * 16;
                float v[2][8];
#pragma unroll
                for (int bj = 0; bj < 2; ++bj)
#pragma unroll
                    for (int n = 0; n < 2; ++n)
#pragma unroll
                        for (int e = 0; e < 4; ++e) v[bj][4 * n + e] = acc[ai][bj][m][n][e];
                if (typ < 2) {
                    float ss = 0.f;
#pragma unroll
                    for (int bj = 0; bj < 2; ++bj)
#pragma unroll
                        for (int j = 0; j < 8; ++j) ss += v[bj][j] * v[bj][j];
                    ss = xsum16(ss); ss = xsum32(ss);
                    const float rs = __builtin_amdgcn_rsqf(ss * (1.0f / 64.0f) + 1e-6f);
#pragma unroll
                    for (int bj = 0; bj < 2; ++bj)
#pragma unroll
                        for (int j = 0; j < 8; ++j) v[bj][j] = v[bj][j] * rs * gn[bj][j];
                    if (grp >= 0) {
                        const float* rp = rope + (size_t)((ml & Lm) >> 4) * 1024 + (size_t)(fr + 16 * fq) * 4;
                        const f32x4 c0 = *(const f32x4*)(rp), c1 = *(const f32x4*)(rp + 256), s0 = *(const f32x4*)(rp + 512), s1 = *(const f32x4*)(rp + 768);
#pragma unroll
                        for (int j = 0; j < 8; ++j) {
                            const float c = j < 4 ? c0[j & 3] : c1[j & 3], s = j < 4 ? s0[j & 3] : s1[j & 3];
                            const float x1 = v[0][j], x2 = v[1][j];
                            v[0][j] = x1 * c - x2 * s; v[1][j] = x2 * c + x1 * s;
                        }
                    }
                }
                u32x4 w[2], r0, r1;
#pragma unroll
                for (int bj = 0; bj < 2; ++bj) { w[bj].x = cvt_pk_bf16(v[bj][0], v[bj][1]); w[bj].y = cvt_pk_bf16(v[bj][2], v[bj][3]); w[bj].z = cvt_pk_bf16(v[bj][4], v[bj][5]); w[bj].w = cvt_pk_bf16(v[bj][6], v[bj][7]); }
                epi_rows(sl, fr, fq, w[0], w[1], r0, r1);
                const int mls = rowb0 + ai * 128 + m * 16 + srow;
                *(u32x4*)(dst + (size_t)perm_row(mls, lgL, ld) * 64) = r0;
                *(u32x4*)(dst + (size_t)perm_row(mls + 8, lgL, ld) * 64) = r1;
                asm volatile("" ::: "memory");
            }
    }
};

struct EpiG2 {
    static constexpr bool MIDK = true;
    unsigned char* ws; LAS unsigned char* lds_epi;
    __device__ __forceinline__ void mid(f32x4 (&acc)[2][2][4][2], const Unit& u, int wr, int wc, int fr, int fq) const {
        const bf16_t* ga = (const bf16_t*)(ws + WS_SMA); const bf16_t* gb = (const bf16_t*)(ws + WS_SMB);
        const int frr = fr & 15, lane = frr + 16 * fq;
        const size_t base = ((size_t)(u.pm * 4 + u.pn) * 8 + (wr * 4 + wc)) * (2 * 4 * 1024) + (size_t)(lane + (fr - frr)) * 8;
#pragma unroll
        for (int ai = 0; ai < 2; ++ai) {
            u32x4 xa[4][2], xb[4][2];
#pragma unroll
            for (int m = 0; m < 4; ++m)
#pragma unroll
                for (int bj = 0; bj < 2; ++bj) { const size_t off = base + (size_t)((ai * 4 + m) * 2 + bj) * 512; xa[m][bj] = *(const u32x4*)(ga + off); xb[m][bj] = *(const u32x4*)(gb + off); }
#pragma unroll
            for (int m = 0; m < 4; ++m)
#pragma unroll
                for (int bj = 0; bj < 2; ++bj) {
                    const u32x4 x = xa[m][bj], y = xb[m][bj];
                    acc[ai][bj][m][0][0] *= bf_lo(x.x) * __builtin_amdgcn_rcpf(bf_lo(y.x)); acc[ai][bj][m][0][1] *= bf_hi(x.x) * __builtin_amdgcn_rcpf(bf_hi(y.x));
                    acc[ai][bj][m][0][2] *= bf_lo(x.y) * __builtin_amdgcn_rcpf(bf_lo(y.y)); acc[ai][bj][m][0][3] *= bf_hi(x.y) * __builtin_amdgcn_rcpf(bf_hi(y.y));
                    acc[ai][bj][m][1][0] *= bf_lo(x.z) * __builtin_amdgcn_rcpf(bf_lo(y.z)); acc[ai][bj][m][1][1] *= bf_hi(x.z) * __builtin_amdgcn_rcpf(bf_hi(y.z));
                    acc[ai][bj][m][1][2] *= bf_lo(x.w) * __builtin_amdgcn_rcpf(bf_lo(y.w)); acc[ai][bj][m][1][3] *= bf_hi(x.w) * __builtin_amdgcn_rcpf(bf_hi(y.w));
                }
            asm volatile("" ::: "memory");
        }
    }
    __device__ __forceinline__ void fin(const f32x4 (&acc)[2][2][4][2], const Unit& u, int wr, int wc, int fr, int fq) const {
        const bf16_t* gb = (const bf16_t*)(ws + WS_SMB); bf16_t* Mg = (bf16_t*)(ws + WS_MERGED);
        LAS unsigned char* sl = lds_epi + (wr * 4 + wc) * EPI_SLICE;
        const int lane = fr + 16 * fq, srow = lane >> 3, spart = lane & 7;
        const size_t base = (size_t)(u.pm * 256 + wr * 64 + srow) * 1024 + u.pn * 256 + wc * 64 + spart * 8;
        const size_t gbase = ((size_t)(u.pm * 4 + u.pn) * 8 + (wr * 4 + wc)) * (2 * 4 * 1024) + (size_t)lane * 8;
#pragma unroll
        for (int ai = 0; ai < 2; ++ai) {
            u32x4 rb[4][2];
#pragma unroll
            for (int m = 0; m < 4; ++m)
#pragma unroll
                for (int bj = 0; bj < 2; ++bj) rb[m][bj] = *(const u32x4*)(gb + gbase + (size_t)((ai * 4 + m) * 2 + bj) * 512);
#pragma unroll
            for (int m = 0; m < 4; ++m) {
                u32x4 w[2], r0, r1;
#pragma unroll
                for (int bj = 0; bj < 2; ++bj) {
                    const u32x4 y = rb[m][bj]; const f32x4 a0 = acc[ai][bj][m][0], a1 = acc[ai][bj][m][1];
                    w[bj].x = cvt_pk_bf16(a0[0] * bf_lo(y.x), a0[1] * bf_hi(y.x)); w[bj].y = cvt_pk_bf16(a0[2] * bf_lo(y.y), a0[3] * bf_hi(y.y));
                    w[bj].z = cvt_pk_bf16(a1[0] * bf_lo(y.z), a1[1] * bf_hi(y.z)); w[bj].w = cvt_pk_bf16(a1[2] * bf_lo(y.w), a1[3] * bf_hi(y.w));
                }
                lane_to_rows(sl, lane, fr, fq, 4 + fq, w[0], w[1], r0, r1);
                bf16_t* op = Mg + base + (size_t)(ai * 128 + m * 16) * 1024;
                *(u32x4*)op = r0; *(u32x4*)(op + 8 * 1024) = r1;
            }
            asm volatile("" ::: "memory");
        }
    }
};

struct EpiG3 {
    static constexpr bool MIDK = false;
    const float* x; float* out; LAS unsigned char* lds_epi;
    __device__ __forceinline__ void fin(const f32x4 (&acc)[2][2][4][2], const Unit& u, int wr, int wc, int fr, int fq) const {
        LAS unsigned char* sl = lds_epi + (wr * 4 + wc) * EPI_SLICE;
        const int lane = fr + 16 * fq, srow = lane >> 3, spart = lane & 7;
        const size_t base = (size_t)(u.pm * 256 + wr * 64 + srow) * 1024 + u.pn * 256 + wc * 64 + spart * 4;
#pragma unroll
        for (int ai = 0; ai < 2; ++ai)
#pragma unroll
            for (int mh = 0; mh < 2; ++mh) {
                u32x4 rx[2][2][2];
#pragma unroll
                for (int mm = 0; mm < 2; ++mm)
#pragma unroll
                    for (int bj = 0; bj < 2; ++bj)
#pragma unroll
                        for (int i = 0; i < 2; ++i) rx[mm][bj][i] = *(const u32x4*)(x + base + (size_t)(ai * 128 + (2 * mh + mm) * 16 + 8 * i) * 1024 + bj * 32);
#pragma unroll
                for (int mm = 0; mm < 2; ++mm)
#pragma unroll
                    for (int bj = 0; bj < 2; ++bj) {
                        const int m = 2 * mh + mm; u32x4 p0, p1, r0, r1;
                        rows_to_lane(sl, lane, fr, 2 * fq, 2 * fq + 1, rx[mm][bj][0], rx[mm][bj][1], p0, p1);
                        const f32x4 o0 = __builtin_bit_cast(f32x4, p0) + acc[ai][bj][m][0], o1 = __builtin_bit_cast(f32x4, p1) + acc[ai][bj][m][1];
                        lane_to_rows(sl, lane, fr, 2 * fq, 2 * fq + 1, __builtin_bit_cast(u32x4, o0), __builtin_bit_cast(u32x4, o1), r0, r1);
                        float* op = out + base + (size_t)(ai * 128 + m * 16) * 1024 + bj * 32;
                        *(u32x4*)op = r0; *(u32x4*)(op + 8 * 1024) = r1;
                    }
                asm volatile("" ::: "memory");
            }
    }
};

struct SchedX {
    const char* ws; size_t offH; int hk, pn_lo, n_pn, G, c;
    __device__ __forceinline__ bool next(int i, Unit& u) const {
        int L = i * G + c;
        if (hk > 0) {
            if (G == 256) {
                const int ng = (64 * n_pn) / 256, hp = (((c >> 3) & 7) * (ng + 1)) >> 3;
                if (i == hp) { pg8::tile_of(c, 64, 4, u.pm, u.pn); u.br = hk; return true; }
                const int j = i < hp ? i : i - 1;
                if (j >= ng) return false;
                L = j * 256 + c;
            } else {
                if (L < 256) { pg8::tile_of(L, 64, 4, u.pm, u.pn); u.br = hk; return true; }
                L -= 256;
            }
        }
        if (L >= 64 * n_pn) return false;
        int pnl; pg8::tile_of(L, 64, n_pn, u.pm, pnl);
        pnl += 4 * (((u.pm >> 3) * (n_pn >> 2)) >> 3); if (pnl >= n_pn) pnl -= n_pn;
        u.pn = pn_lo + pnl; u.br = 0; return true;
    }
    __device__ __forceinline__ const char* a_ptr(const Unit& u) const { const size_t off = u.br == 0 ? offH : (u.br == 1 ? WS_OA : WS_MERGED); return ws + off + (size_t)u.pm * (256 * 1024 * 2); }
    __device__ __forceinline__ const char* b_ptr(const Unit& u) const { const size_t off = u.br == 0 ? WS_WIN : (u.br == 1 ? WS_WA : WS_WO); return ws + off + (size_t)u.pn * (256 * 1024 * 2); }
};
struct EpiX {
    static constexpr bool MIDK = true;
    EpiG1 e1; EpiG2 e2; EpiG3 e3;
    __device__ __forceinline__ void mid(f32x4 (&acc)[2][2][4][2], const Unit& u, int wr, int wc, int fr, int fq) const { if (u.br == 1) e2.mid(acc, u, wr, wc, fr, fq); }
    __device__ __forceinline__ void fin(const f32x4 (&acc)[2][2][4][2], const Unit& u, int wr, int wc, int fr, int fq) const {
        if (u.br == 0) e1.fin(acc, u, wr, wc, fr, fq); else if (u.br == 1) e2.fin(acc, u, wr, wc, fr, fq); else e3.fin(acc, u, wr, wc, fr, fq);
    }
};

__device__ __forceinline__ void p0_transpose_item(const float* W, int K, int N, bf16_t* WT, int ldw, LAS float* scr, int item, int lane) {
    const int nblk = N / 32, kb = item / nblk, nb = item % nblk, k0 = 64 * kb, n0 = 32 * nb;
    float wv[32];
#pragma unroll
    for (int i = 0; i < 32; ++i) wv[i] = W[(size_t)(k0 + 2 * i + (lane >> 5)) * N + n0 + (lane & 31)];
#pragma unroll
    for (int i = 0; i < 32; ++i) scr[(2 * i + (lane >> 5)) * 33 + (lane & 31)] = wv[i];
    asm volatile("s_waitcnt lgkmcnt(0)" ::: "memory");
    const int c = lane & 7;
#pragma unroll
    for (int j = 0; j < 4; ++j) { const int n = (lane >> 3) + 8 * j; const LAS float* s = scr + (8 * c) * 33 + n;
        u32x4 o; o.x = cvt_pk_bf16(s[0 * 33], s[1 * 33]); o.y = cvt_pk_bf16(s[2 * 33], s[3 * 33]); o.z = cvt_pk_bf16(s[4 * 33], s[5 * 33]); o.w = cvt_pk_bf16(s[6 * 33], s[7 * 33]);
        *(u32x4*)(WT + (size_t)(n0 + n) * ldw + k0 + 8 * c) = o; }
    asm volatile("s_waitcnt lgkmcnt(0)" ::: "memory");
}

__device__ __forceinline__ void sincos_d(double x, float& s, float& c) {
    const double n = rint(x * 0.15915494309189535);
    double r = fma(-n, 6.283185307179586, x); r = fma(-n, 2.4492935982947064e-16, r);
    const double r2 = r * r;
    double ts = r, tc = 1.0, ss = r, cc = 1.0;
#pragma unroll
    for (int k = 1; k <= 14; ++k) {
        tc *= -r2 * (1.0 / (double)((2 * k - 1) * (2 * k))); cc += tc;
        ts *= -r2 * (1.0 / (double)((2 * k) * (2 * k + 1))); ss += ts;
    }
    s = (float)ss; c = (float)cc;
}

struct Args { const float* in[12]; float* out; unsigned char* ws; int ph_lo, ph_hi; };

__device__ __forceinline__ const float* x_row(const Args& a, int m) { return m < 32768 ? a.in[0] + (size_t)m * DM : a.in[1] + (size_t)(m - 32768) * DM; }

__device__ __forceinline__ void p0_prologue(const Args& a, LAS unsigned char* lds, int G) {
    const int tid = opaque_tid(), lane = tid & 63, wave = tid >> 6;
    LAS float* scr = (LAS float*)(lds + wave * 16384);
    const int gw = blockIdx.x * NWAVES + wave, NGW = G * NWAVES;
    constexpr int I_IN = 16 * 288, I_A = 8 * 32, I_O = 16 * 32;
    for (int it = gw; it < I_IN + 2 * I_A + I_O; it += NGW) {
        int r = it;
        if (r < I_IN) { p0_transpose_item(a.in[3], 1024, DIN, (bf16_t*)(a.ws + WS_WIN), 1024, scr, r, lane); continue; } r -= I_IN;
        if (r < I_A) { p0_transpose_item(a.in[9], 512, 1024, (bf16_t*)(a.ws + WS_WA), 1024, scr, r, lane); continue; } r -= I_A;
        if (r < I_A) { p0_transpose_item(a.in[10], 512, 1024, (bf16_t*)(a.ws + WS_WA) + 512, 1024, scr, r, lane); continue; } r -= I_A;
        p0_transpose_item(a.in[11], 1024, 1024, (bf16_t*)(a.ws + WS_WO), 1024, scr, r, lane);
    }
    if (blockIdx.x == 0 && tid < 64) {
        float* gt = (float*)(a.ws + WS_GAINS);
        gt[tid] = a.in[4][tid]; gt[64 + tid] = a.in[5][tid]; gt[128 + tid] = a.in[7][tid]; gt[192 + tid] = a.in[8][tid];
    }
    float* rope = (float*)(a.ws + WS_ROPE);
    for (int i = blockIdx.x * NTHREADS + tid; i < 16384 * 32; i += G * NTHREADS) {
        const int t = i >> 5, f = i & 31; const float ang = (float)t * INV_FREQ[f];
        float s, c; sincos_d((double)ang, s, c);
        { const size_t b = (size_t)(t >> 4) * 1024 + (size_t)(((f >> 2) & 1) * 256) + (size_t)((t & 15) + 16 * (f >> 3)) * 4 + (f & 3); rope[b] = c; rope[b + 512] = s; }
    }
    const float* gain = a.in[2];
    f32x4 gv[4];
#pragma unroll
    for (int j = 0; j < 4; ++j) gv[j] = *(const f32x4*)(gain + 4 * lane + 256 * j);
    bf16_t* H = (bf16_t*)(a.ws + WS_H);
    for (int m0 = gw * 8; m0 < RT; m0 += NGW * 8) {
        f32x4 v[8][4]; float s[8];
#pragma unroll
        for (int rr = 0; rr < 8; ++rr) { const f32x4* xr = (const f32x4*)x_row(a, m0 + rr) + lane;
#pragma unroll
            for (int j = 0; j < 4; ++j) v[rr][j] = xr[64 * j]; }
#pragma unroll
        for (int rr = 0; rr < 8; ++rr) { float t = 0.f;
#pragma unroll
            for (int j = 0; j < 4; ++j) t += (v[rr][j].x * v[rr][j].x + v[rr][j].y * v[rr][j].y) + (v[rr][j].z * v[rr][j].z + v[rr][j].w * v[rr][j].w);
            s[rr] = t; }
#pragma unroll
        for (int o = 1; o < 64; o <<= 1) {
#pragma unroll
            for (int rr = 0; rr < 8; ++rr) s[rr] += __shfl_xor(s[rr], o);
        }
#pragma unroll
        for (int rr = 0; rr < 8; ++rr) {
            const float rstd = 1.0f / sqrtf(s[rr] * (1.0f / DM) + 1e-6f);
            u32x2* o8 = (u32x2*)(H + (size_t)(m0 + rr) * DM) + lane;
#pragma unroll
            for (int j = 0; j < 4; ++j) { u32x2 w; w.x = cvt_pk_bf16(v[rr][j].x * rstd * gv[j].x, v[rr][j].y * rstd * gv[j].y); w.y = cvt_pk_bf16(v[rr][j].z * rstd * gv[j].z, v[rr][j].w * rstd * gv[j].w); o8[64 * j] = w; }
        }
    }
}

typedef short v4i16_t __attribute__((ext_vector_type(4)));
constexpr int ATT_O_OFF = 0;
constexpr int ATT_LSE_OFF = 65536;
constexpr int ATT_BIAS_OFF = 67584;
constexpr int ATT_NEG_OFF = 82464;
constexpr int ATT_VSCR_OFF = 83968;
constexpr int VROW = 160;

template <int NQT, int NKT, int KB, class KF_t, class MF_t>
__device__ __forceinline__ void attn_core(const bf16_t* qbase, const KF_t& KF, const MF_t& MF, LAS unsigned char* vscr, int lane,
                                          f32x4 (&o)[NQT][4], float (&mx)[NQT], float (&l)[NQT]) {
    const int fr = lane & 15, fq = lane >> 4;
    constexpr int NB = NKT / KB;
    const int vrow = (lane >> 3), vpart = lane & 7;
    bf16x8 qf[NQT][2];
    {
        u32x4 qr[NQT][2];
#pragma unroll
        for (int qt = 0; qt < NQT; ++qt)
#pragma unroll
            for (int i = 0; i < 2; ++i) qr[qt][i] = *(const u32x4*)(qbase + (size_t)(16 * qt + vrow + 8 * i) * 64 + vpart * 8);
#pragma unroll
        for (int qt = 0; qt < NQT; ++qt)
#pragma unroll
            for (int i = 0; i < 2; ++i) *(LAS u32x4*)(vscr + (16 * qt + vrow + 8 * i) * VROW + vpart * 16) = qr[qt][i];
#pragma unroll
        for (int qt = 0; qt < NQT; ++qt)
#pragma unroll
            for (int ks = 0; ks < 2; ++ks) qf[qt][ks] = *(const LAS bf16x8*)(vscr + (16 * qt + fr) * VROW + ks * 64 + fq * 16);
    }
    u32x4 kr[NKT / 2][4];
#pragma unroll
    for (int kb = 0; kb < NKT / 2; ++kb)
#pragma unroll
        for (int i = 0; i < 4; ++i) kr[kb][i] = *(const u32x4*)(KF.kptr(2 * kb + (i >> 1)) + ((vrow + 8 * i) & 15) * 64 + vpart * 8);
    __builtin_amdgcn_sched_barrier(0);
    f32x4 s[NQT][NKT];
#pragma unroll
    for (int kb = 0; kb < NKT / 2; ++kb) {
#pragma unroll
        for (int i = 0; i < 4; ++i) *(LAS u32x4*)(vscr + (vrow + 8 * i) * VROW + vpart * 16) = kr[kb][i];
#pragma unroll
        for (int tt = 0; tt < 2; ++tt) {
            const int t = 2 * kb + tt;
            const bf16x8 k0 = *(const LAS bf16x8*)(vscr + (16 * tt + fr) * VROW + fq * 16), k1 = *(const LAS bf16x8*)(vscr + (16 * tt + fr) * VROW + 64 + fq * 16);
#pragma unroll
            for (int qt = 0; qt < NQT; ++qt) {
                f32x4 z = (f32x4){-1e30f, -1e30f, -1e30f, -1e30f};
                if (!MF.skip(qt, t)) {
                    z = (f32x4){0.f, 0.f, 0.f, 0.f};
                    z = __builtin_amdgcn_mfma_f32_16x16x32_bf16(k0, qf[qt][0], z, 0, 0, 0);
                    z = __builtin_amdgcn_mfma_f32_16x16x32_bf16(k1, qf[qt][1], z, 0, 0, 0);
                    MF.apply(qt, t, z);
                }
                s[qt][t] = z;
            }
        }
    }
    __builtin_amdgcn_sched_barrier(0);
    u32x4 vr[NKT / 2][4];
#pragma unroll
    for (int kb = 0; kb < NKT / 2; ++kb)
#pragma unroll
        for (int i = 0; i < 4; ++i) vr[kb][i] = *(const u32x4*)(KF.vptr(2 * kb + (i >> 1)) + ((vrow + 8 * i) & 15) * 64 + vpart * 8);
    __builtin_amdgcn_sched_barrier(0);
#pragma unroll
    for (int qt = 0; qt < NQT; ++qt) {
        float m4[4] = {-1e30f, -1e30f, -1e30f, -1e30f};
#pragma unroll
        for (int t = 0; t < NKT; ++t) if (!MF.skip(qt, t)) {
#pragma unroll
            for (int e = 0; e < 4; ++e) m4[e] = fmaxf(m4[e], s[qt][t][e]);
        }
        float m = fmaxf(fmaxf(m4[0], m4[1]), fmaxf(m4[2], m4[3]));
        m = xmax16(m); m = xmax32(m);
        float s4[4] = {0.f, 0.f, 0.f, 0.f};
#pragma unroll
        for (int t = 0; t < NKT; ++t) {
            if (MF.skip(qt, t)) { s[qt][t] = (f32x4){0.f, 0.f, 0.f, 0.f}; continue; }
#pragma unroll
            for (int e = 0; e < 4; ++e) { const float p = fast_exp2(s[qt][t][e] - m); s[qt][t][e] = p; s4[e] += p; }
        }
        float sum = (s4[0] + s4[1]) + (s4[2] + s4[3]);
        sum = xsum16(sum); sum = xsum32(sum);
        mx[qt] = m; l[qt] = sum;
#pragma unroll
        for (int nd = 0; nd < 4; ++nd) o[qt][nd] = (f32x4){0.f, 0.f, 0.f, 0.f};
    }
    const int trow = (4 * fq + (fr >> 2)) * VROW + 8 * (fr & 3);
#pragma unroll
    for (int kb = 0; kb < NKT / 2; ++kb) {
#pragma unroll
        for (int i = 0; i < 4; ++i) *(LAS u32x4*)(vscr + (vrow + 8 * i) * VROW + vpart * 16) = vr[kb][i];
        bf16x8 pf[NQT];
#pragma unroll
        for (int qt = 0; qt < NQT; ++qt) {
            u32x4 w; w.x = cvt_pk_bf16(s[qt][2 * kb][0], s[qt][2 * kb][1]); w.y = cvt_pk_bf16(s[qt][2 * kb][2], s[qt][2 * kb][3]);
            w.z = cvt_pk_bf16(s[qt][2 * kb + 1][0], s[qt][2 * kb + 1][1]); w.w = cvt_pk_bf16(s[qt][2 * kb + 1][2], s[qt][2 * kb + 1][3]);
            pf[qt] = __builtin_bit_cast(bf16x8, w);
        }
#pragma unroll
        for (int nd = 0; nd < 4; ++nd) {
            const v4i16_t a0 = __builtin_amdgcn_ds_read_tr16_b64_v4i16((LAS v4i16_t*)(vscr + trow + 32 * nd));
            const v4i16_t a1 = __builtin_amdgcn_ds_read_tr16_b64_v4i16((LAS v4i16_t*)(vscr + trow + 16 * VROW + 32 * nd));
            bf16x8 vf; vf[0] = a0[0]; vf[1] = a0[1]; vf[2] = a0[2]; vf[3] = a0[3]; vf[4] = a1[0]; vf[5] = a1[1]; vf[6] = a1[2]; vf[7] = a1[3];
#pragma unroll
            for (int qt = 0; qt < NQT; ++qt) o[qt][nd] = __builtin_amdgcn_mfma_f32_16x16x32_bf16(vf, pf[qt], o[qt][nd], 0, 0, 0);
        }
    }
}

struct DilKF {
    const bf16_t* K; const bf16_t* V; int start0, n;
    __device__ __forceinline__ const bf16_t* kptr(int t) const { const int st = start0 + 16 * t; return K + (size_t)((st >= 0 && st < n) ? st : 0) * 64; }
    __device__ __forceinline__ const bf16_t* vptr(int t) const { const int st = start0 + 16 * t; return V + (size_t)((st >= 0 && st < n) ? st : 0) * 64; }
};
struct DilMF {
    int start0, n, fr, fq;
    __device__ __forceinline__ bool skip(int qt, int t) const { const int d = t - qt; return d <= -1 || d >= 9; }
    __device__ __forceinline__ void apply(int qt, int t, f32x4& z) const {
        const int st = start0 + 16 * t; const bool tv = (st >= 0 && st < n);
        const int d = t - qt;
        if (d >= 1 && d <= 7) {
#pragma unroll
            for (int e = 0; e < 4; ++e) z[e] = tv ? z[e] : -1e30f;
        } else {
            const int rel0 = 16 * t + 4 * fq - 64 - 16 * qt - fr;
#pragma unroll
            for (int e = 0; e < 4; ++e) { const int rel = rel0 + e; z[e] = (tv && rel >= -64 && rel <= 64) ? z[e] : -1e30f; }
        }
    }
};
struct NaKF {
    const bf16_t* K; const bf16_t* V; int row0;
    __device__ __forceinline__ const bf16_t* kptr(int t) const { return K + (size_t)(row0 + (t >> 1) * 64 + 16 * (t & 1)) * 64; }
    __device__ __forceinline__ const bf16_t* vptr(int t) const { return V + (size_t)(row0 + (t >> 1) * 64 + 16 * (t & 1)) * 64; }
};
struct NaMF {
    const LAS float* bp[2][4];
    __device__ __forceinline__ bool skip(int, int) const { return false; }
    __device__ __forceinline__ void apply(int qt, int t, f32x4& z) const {
#pragma unroll
        for (int e = 0; e < 4; ++e) z[e] += bp[t & 1][e][(t >> 1) * 31];
    }
};

__device__ __forceinline__ void gate_out_tile(LAS unsigned char* sc, int lane, const u32x4 (&gl)[2], const f32x4 (&v)[4], u32x4 (&outr)[2]) {
    const int fr = lane & 15, fq = lane >> 4, row = lane >> 3, part = lane & 7;
    *(LAS u32x4*)(sc + row * VROW + part * 16) = gl[0]; *(LAS u32x4*)(sc + (row + 8) * VROW + part * 16) = gl[1];
    u32x2 g[4], w[4];
#pragma unroll
    for (int nd = 0; nd < 4; ++nd) g[nd] = *(const LAS u32x2*)(sc + fr * VROW + 32 * nd + 8 * fq);
#pragma unroll
    for (int nd = 0; nd < 4; ++nd) { w[nd].x = cvt_pk_bf16(v[nd][0] * bf_lo(g[nd].x), v[nd][1] * bf_hi(g[nd].x)); w[nd].y = cvt_pk_bf16(v[nd][2] * bf_lo(g[nd].y), v[nd][3] * bf_hi(g[nd].y)); }
#pragma unroll
    for (int nd = 0; nd < 4; ++nd) *(LAS u32x2*)(sc + fr * VROW + 32 * nd + 8 * fq) = w[nd];
    outr[0] = *(const LAS u32x4*)(sc + row * VROW + part * 16); outr[1] = *(const LAS u32x4*)(sc + (row + 8) * VROW + part * 16);
}

__device__ __forceinline__ void h_row_finish(const Args& a, int m, int lane, const f32x4 (&v)[4]) {
    float s = 0.f;
#pragma unroll
    for (int j = 0; j < 4; ++j) s += (v[j].x * v[j].x + v[j].y * v[j].y) + (v[j].z * v[j].z + v[j].w * v[j].w);
    const float rstd = __builtin_amdgcn_rsqf(wave_sum(s) * (1.0f / DM) + 1e-6f);
    const f32x4* gp = (const f32x4*)a.in[2] + lane;
    u32x2* o8 = (u32x2*)((bf16_t*)(a.ws + WS_H) + (size_t)m * DM) + lane;
#pragma unroll
    for (int j = 0; j < 4; ++j) { const f32x4 g = gp[64 * j]; u32x2 w; w.x = cvt_pk_bf16(v[j].x * rstd * g.x, v[j].y * rstd * g.y); w.y = cvt_pk_bf16(v[j].z * rstd * g.z, v[j].w * rstd * g.w); o8[64 * j] = w; }
}

__device__ __forceinline__ void attn_phase(const Args& a, LAS unsigned char* lds, int lgL, int G, int hrow0) {
    const int tid = opaque_tid(), lane = tid & 63, wave = __builtin_amdgcn_readfirstlane(tid >> 6), fr = lane & 15, fq = lane >> 4;
    const int L = 1 << lgL;
    LAS float* biasl = (LAS float*)(lds + ATT_BIAS_OFF);
    for (int i = tid; i < 8 * 15 * 31; i += NTHREADS) biasl[i] = a.in[6][i] * LOG2E;
    if (tid < 256) ((LAS float*)(lds + ATT_NEG_OFF))[tid] = -1e30f;
    LAS unsigned char* vscr = lds + ATT_VSCR_OFF + wave * 5120;
    LAS bf16_t* ol = (LAS bf16_t*)(lds + ATT_O_OFF);
    LAS float* lsel = (LAS float*)(lds + ATT_LSE_OFF);
    __syncthreads();
    const int vb = (G % 8 == 0) ? (int)(blockIdx.x % 8) * (G / 8) + (int)(blockIdx.x / 8) : (int)blockIdx.x;
#ifndef ATT_DIL_REP
#define ATT_DIL_REP 1
#endif
#ifndef ATT_NA_REP
#define ATT_NA_REP 1
#endif
    const bool h_fused = (hrow0 >= 0) && (G == NHEAD * (RT / 512));
    const int hbase = hrow0 + ((int)blockIdx.x * NWAVES + wave) * 8;
    if (hrow0 >= 0) {
        for (int m = (int)blockIdx.x * NWAVES + wave; m < RT / 8 && !h_fused; m += G * NWAVES) {
#pragma unroll 1
            for (int q = 0; q < 8; ++q) { f32x4 v[4]; const f32x4* xr = (const f32x4*)x_row(a, hrow0 + m * 8 + q) + lane;
#pragma unroll
                for (int j = 0; j < 4; ++j) v[j] = xr[64 * j];
                h_row_finish(a, hrow0 + m * 8 + q, lane, v); }
        }
        if (h_fused) {
            f32x4 v[2][4];
#pragma unroll
            for (int q = 0; q < 2; ++q) { const f32x4* xr = (const f32x4*)x_row(a, hbase + 6 + q) + lane;
#pragma unroll
                for (int j = 0; j < 4; ++j) v[q][j] = xr[64 * j]; }
#pragma unroll
            for (int q = 0; q < 2; ++q) h_row_finish(a, hbase + 6 + q, lane, v[q]);
        }
    }
    for (int rep_ = 0; rep_ < ATT_DIL_REP; ++rep_)
    for (int unit = vb; unit < NHEAD * (RT / 512); unit += G) {
        const int head = unit >> 5, ml0 = (unit & 31) * 512, t0 = ml0 & (L - 1), sb = ml0 - t0;
#pragma unroll 1
        for (int g = 0; g < 3; ++g) {
            const int ld = 2 * g, n = L >> ld;
            const bf16_t* QG = (const bf16_t*)(a.ws + WS_HL + (size_t)(3 + 3 * g) * HL_BYTES) + (size_t)head * RT * 64;
            const bf16_t* KG = QG + HL_BYTES / 2; const bf16_t* VG = KG + HL_BYTES / 2;
#pragma unroll 1
            for (int kk = 0; kk < 2; ++kk) {
                const int k = 2 * wave + kk, sidx = k >> (4 - ld), p = k & ((16 >> ld) - 1);
                const int i0 = (t0 >> ld) + 32 * p, sub = sb + sidx * n;
                DilKF KF{KG + (size_t)sub * 64, VG + (size_t)sub * 64, i0 - 64, n};
                DilMF MF{i0 - 64, n, fr, fq};
                f32x4 hx[4];
                if (h_fused) { const f32x4* xr = (const f32x4*)x_row(a, hbase + 2 * g + kk) + lane;
#pragma unroll
                    for (int j = 0; j < 4; ++j) hx[j] = xr[64 * j]; }
                u32x4 gl[2][2];
                if (g == 2) {
#pragma unroll
                    for (int qt = 0; qt < 2; ++qt)
#pragma unroll
                        for (int i = 0; i < 2; ++i) {
                            const int tlr = sidx + ((32 * p + 16 * qt + (lane >> 3) + 8 * i) << ld);
                            gl[qt][i] = *(const u32x4*)((const bf16_t*)(a.ws + WS_SGB) + (size_t)(ml0 + tlr) * 512 + head * 64 + (lane & 7) * 8);
                        }
                }
                f32x4 o[2][4]; float mx[2], l[2];
                attn_core<2, 10, 10>(QG + (size_t)(sub + i0) * 64, KF, MF, vscr, lane, o, mx, l);
#pragma unroll
                for (int qt = 0; qt < 2; ++qt) {
                    const int tl = sidx + ((32 * p + 16 * qt + fr) << ld);
                    float lse = mx[qt] + __builtin_amdgcn_logf(l[qt]);
                    const float inv = __builtin_amdgcn_rcpf(l[qt]);
                    float wn = 1.0f, wo = 0.0f;
                    if (g > 0) {
                        const float lo_ = lsel[tl]; const float M = fmaxf(lo_, lse);
                        const float eo = fast_exp2(lo_ - M), en = fast_exp2(lse - M), sm = eo + en;
                        { const float rsm = __builtin_amdgcn_rcpf(sm); wo = eo * rsm; wn = en * rsm; } lse = M + __builtin_amdgcn_logf(sm);
                    }
                    f32x4 vv[4];
#pragma unroll
                    for (int nd = 0; nd < 4; ++nd) {
                        f32x4 v = o[qt][nd] * (inv * wn);
                        LAS u32x2* op = (LAS u32x2*)(ol + tl * 64 + 16 * nd + 4 * fq);
                        if (g > 0) { const u32x2 w = *op; v[0] += wo * bf_lo(w.x); v[1] += wo * bf_hi(w.x); v[2] += wo * bf_lo(w.y); v[3] += wo * bf_hi(w.y); }
                        if (g < 2) { u32x2 w; w.x = cvt_pk_bf16(v[0], v[1]); w.y = cvt_pk_bf16(v[2], v[3]); *op = w; }
                        vv[nd] = v;
                    }
                    if (g == 2) {
                        u32x4 outr[2];
                        gate_out_tile(vscr + qt * (16 * VROW), lane, gl[qt], vv, outr);
#pragma unroll
                        for (int i = 0; i < 2; ++i) {
                            const int tlr = sidx + ((32 * p + 16 * qt + (lane >> 3) + 8 * i) << ld);
                            *(u32x4*)((bf16_t*)(a.ws + WS_OA) + (size_t)(ml0 + tlr) * 1024 + 512 + head * 64 + (lane & 7) * 8) = outr[i];
                        }
                    }
                    if (g < 2 && fq == 0) lsel[tl] = lse;
                }
                if (h_fused) h_row_finish(a, hbase + 2 * g + kk, lane, hx);
            }
            asm volatile("s_waitcnt lgkmcnt(0)" ::: "memory"); __builtin_amdgcn_s_barrier(); asm volatile("" ::: "memory");
        }
    }
    {
        const bf16_t* QA0 = (const bf16_t*)(a.ws + WS_HL);
        const int rows = L >> 6;
#pragma unroll 1
        for (int rep_ = 0; rep_ < ATT_NA_REP; ++rep_)
#pragma unroll 1
        for (int task = vb * NWAVES + wave; task < NHEAD * (RT / 64) * 4; task += G * NWAVES) {
            const int nblk = task & 3, row64 = (task >> 2) & (RT / 64 - 1), head = task >> 10;
            const int ml0 = row64 * 64 + 16 * nblk, t = ml0 & (L - 1), sb = ml0 - t, r = t >> 6;
            int rs = r - 4; rs = rs < 0 ? 0 : (rs > rows - 8 ? rows - 8 : rs);
            int kb = 16 * nblk - 8; kb = kb < 0 ? 0 : (kb > 32 ? 32 : kb);
            const int qc = 16 * nblk + fr; int cst = qc - 8; cst = cst < 0 ? 0 : (cst > 48 ? 48 : cst);
            const bf16_t* QA = QA0 + (size_t)head * RT * 64; const bf16_t* KA = QA + HL_BYTES / 2; const bf16_t* VA = KA + HL_BYTES / 2;
            NaKF KF{KA, VA, sb + rs * 64 + kb};
            NaMF MF;
#pragma unroll
            for (int tb = 0; tb < 2; ++tb)
#pragma unroll
                for (int e = 0; e < 4; ++e) {
                    const int kc = kb + 16 * tb + 4 * fq + e; int dc = kc - qc; dc = dc < -15 ? -15 : (dc > 15 ? 15 : dc);
                    const bool ok = (kc >= cst && kc < cst + 16);
                    MF.bp[tb][e] = ok ? (biasl + (head * 15 + (rs - r + 7)) * 31 + dc + 15) : (const LAS float*)(lds + ATT_NEG_OFF);
                }
            u32x4 gl[2];
#pragma unroll
            for (int i = 0; i < 2; ++i) gl[i] = *(const u32x4*)((const bf16_t*)(a.ws + WS_SGA) + (size_t)(ml0 + (lane >> 3) + 8 * i) * 512 + head * 64 + (lane & 7) * 8);
            f32x4 o[1][4]; float mx[1], l[1];
            attn_core<1, 16, 16>(QA + (size_t)ml0 * 64, KF, MF, vscr, lane, o, mx, l);
            const float inv = __builtin_amdgcn_rcpf(l[0]);
            f32x4 vv[4]; u32x4 outr[2];
#pragma unroll
            for (int nd = 0; nd < 4; ++nd) vv[nd] = o[0][nd] * inv;
            gate_out_tile(vscr, lane, gl, vv, outr);
#pragma unroll
            for (int i = 0; i < 2; ++i) *(u32x4*)((bf16_t*)(a.ws + WS_OA) + (size_t)(ml0 + (lane >> 3) + 8 * i) * 1024 + head * 64 + (lane & 7) * 8) = outr[i];
        }
    }
    __syncthreads();
}

#define XB_TMO      128
#define XB_XCNT(j)  (256  + 64 * (j))
#define XB_XSUB(j)  (1280 + 64 * (j))
#define XB_XGEN(j)  (2304 + 64 * (j))
#define XB_TOP      3328
#define XB_TOPGEN   3392
#define XCD_BAR_WORDS 3456
#define XB_SPIN_CAP (1u << 18)

__device__ __forceinline__ unsigned xb_ld(unsigned* p)              { return __hip_atomic_load(p, __ATOMIC_RELAXED, __HIP_MEMORY_SCOPE_AGENT); }
__device__ __forceinline__ unsigned xb_add(unsigned* p, unsigned v) { return __hip_atomic_fetch_add(p, v, __ATOMIC_RELAXED, __HIP_MEMORY_SCOPE_AGENT); }
__device__ __forceinline__ unsigned xb_xcc_id() { return (unsigned)__builtin_amdgcn_s_getreg((3 << 11) | 20) & 0xFu; }
#define XB_SPIN(cond, bar) do { unsigned _sp = 0; while (cond) { __builtin_amdgcn_s_sleep(1); \
    if ((++_sp & 255u) == 0u) { if (xb_ld(&(bar)[XB_TMO])) break; if (_sp > XB_SPIN_CAP) { atomicAdd(&(bar)[XB_TMO], 1u); break; } } } } while (0)

struct XcdBarrier {
    unsigned* bar; unsigned x;
    volatile LAS unsigned* st;
};

__device__ __forceinline__ XcdBarrier xcd_barrier_post(unsigned* bar, volatile LAS unsigned* st) {
    XcdBarrier b; b.bar = bar; b.x = xb_xcc_id(); b.st = st;
    if (threadIdx.x == 0) (void)xb_add(&bar[XB_XCNT(b.x)], 1u);
    return b;
}
__device__ __forceinline__ void xcd_barrier_complete(unsigned* bar, unsigned x, unsigned& nloc, unsigned& nx) {
    const unsigned G = gridDim.x * gridDim.y * gridDim.z;
    unsigned sum, cnt, mine, sp = 0u;
    for (;;) {
        sum = 0u; cnt = 0u; mine = 0u;
#pragma unroll
        for (unsigned j = 0; j < 16; ++j) { const unsigned c = xb_ld(&bar[XB_XCNT(j)]); sum += c; cnt += (c > 0u) ? 1u : 0u; mine = (j == x) ? c : mine; }
        if (sum == G) break;
        __builtin_amdgcn_s_sleep(1);
        if ((++sp & 255u) == 0u) { if (xb_ld(&bar[XB_TMO])) break; if (sp > XB_SPIN_CAP) { atomicAdd(&bar[XB_TMO], 1u); break; } }
    }
    nloc = mine > 0u ? mine : 1u; nx = cnt > 0u ? cnt : 1u;
}

__device__ __forceinline__ void xcd_barrier(const XcdBarrier& b) {
    asm volatile("s_waitcnt vmcnt(0)" ::: "memory");
    __syncthreads();
    if (threadIdx.x == 0) {
        unsigned* bar = b.bar;
        __builtin_amdgcn_s_waitcnt(0);
        unsigned nloc = b.st[0], nx = b.st[1];
        if (nloc == 0u) { xcd_barrier_complete(bar, b.x, nloc, nx); b.st[0] = nloc; b.st[1] = nx; }
        const unsigned old = xb_add(&bar[XB_XSUB(b.x)], 1u);
        const unsigned gen = old / nloc;
        if (old + 1u == (gen + 1u) * nloc) {
            __builtin_amdgcn_fence(__ATOMIC_RELEASE, "agent");
            asm volatile("s_waitcnt vmcnt(0)" ::: "memory");
            const unsigned og = xb_add(&bar[XB_TOP], 1u);
            const unsigned tg = og / nx;
            if (og + 1u == (tg + 1u) * nx) xb_add(&bar[XB_TOPGEN], 1u);
            else XB_SPIN(xb_ld(&bar[XB_TOPGEN]) == tg, bar);
            __builtin_amdgcn_fence(__ATOMIC_ACQUIRE, "agent");
            xb_add(&bar[XB_XGEN(b.x)], 1u);
            asm volatile("s_waitcnt vmcnt(0)" ::: "memory");
        } else {
            XB_SPIN(xb_ld(&bar[XB_XGEN(b.x)]) == gen, bar);
            __builtin_amdgcn_fence(__ATOMIC_ACQUIRE, "agent");
            asm volatile("s_waitcnt vmcnt(0)" ::: "memory");
        }
    }
    __syncthreads();
}

constexpr int LDS_BYTES = 155648;
constexpr int N_PHASES = 3 + 2 * NROUND;

__global__ void __launch_bounds__(NTHREADS, 2) mk_fwd(Args args) {
    extern __shared__ __attribute__((aligned(16))) unsigned char lds_raw[];
    LAS unsigned char* lds = (LAS unsigned char*)lds_raw;
    const int G = gridDim.x;
    const int lo = args.ph_lo, hi = args.ph_hi;
    const bool coop = (hi - lo) > 1;
    volatile LAS unsigned* bar_st = (volatile LAS unsigned*)(lds + 131072);
    if (threadIdx.x < 2) bar_st[threadIdx.x] = 0u;
    __syncthreads();
    XcdBarrier bar; bar.bar = (unsigned*)(args.ws + WS_BAR); bar.x = 0; bar.st = bar_st;
    if (coop) bar = xcd_barrier_post((unsigned*)(args.ws + WS_BAR), bar_st);
    if (lo < 0) cg::this_grid().sync();
#ifndef PROBE_REPEAT
#define PROBE_REPEAT -1
#endif
    for (int ph2 = 2 * lo; ph2 < 2 * hi; ++ph2) {
        const int ph = ph2 >> 1;
        const int kind = ph == 0 ? 0 : (ph == 1 ? 1 : (ph == 2 ? 2 : 3 + ((ph - 3) & 1)));
        if ((ph2 & 1) && kind != PROBE_REPEAT) continue;
        if (kind == 0) {
            p0_prologue(args, lds, G);
        } else if (kind == 2) {
            attn_phase(args, lds, 12, G, RT);
        } else {
            const int r = kind == 1 ? -1 : (ph - 3) >> 1;
            const int rr = r + 1;
            const int rq = r < 0 ? 0 : r;
            SchedX S{(const char*)args.ws, WS_H + (size_t)(rr < NROUND ? rr : 0) * RT * DM * 2, kind == 1 ? 0 : kind - 2, kind == 4 ? 28 : 0,
                     rr >= NROUND ? 0 : (kind == 1 ? 36 : (kind == 3 ? 28 : 8)), G, (int)blockIdx.x};
            EpiX E{EpiG1{args.ws, rr < 2 ? 12 : 14, lds + EPI_LDS_OFF}, EpiG2{args.ws, lds + EPI_LDS_OFF}, EpiG3{x_row(args, rq * RT), args.out + (size_t)rq * RT * DM, lds + EPI_LDS_OFF}};
            const bool has_att = (kind == 4 && rr < NROUND);
            const bool att_first = has_att && (blockIdx.x & 1);
#pragma unroll 1
            for (int step = 0; step < 2; ++step) {
                if ((step == 0) != att_first) pg8::gemm_phase<1024>(lds, S, E);
                else if (has_att) attn_phase(args, lds, rr < 2 ? 12 : 14, G, rr + 1 < NROUND ? (rr + 1) * RT : -1);
            }
        }
        if (coop && ph2 + 1 < 2 * hi) { xcd_barrier(bar); }
    }
}

#ifndef MK_ONE_LAUNCH
#define MK_ONE_LAUNCH 1
#endif
extern "C" void kernel_launch(void* const* d_in, const int* in_sizes, int n_in, void* d_out, int out_size, void* d_ws, size_t ws_size, hipStream_t stream) {
    static int grid = 0;
    if (grid == 0) {
        if (n_in != 12 || ws_size < WS_END) { fprintf(stderr, "kernel_launch: unexpected n_in %d / ws %zu\n", n_in, ws_size); grid = -1; return; }
        int dev = 0, cus = 0, per_cu = 0;
        (void)hipGetDevice(&dev); (void)hipDeviceGetAttribute(&cus, hipDeviceAttributeMultiprocessorCount, dev);
        (void)hipFuncSetAttribute((const void*)mk_fwd, hipFuncAttributeMaxDynamicSharedMemorySize, LDS_BYTES);
        (void)hipOccupancyMaxActiveBlocksPerMultiprocessor(&per_cu, (const void*)mk_fwd, NTHREADS, LDS_BYTES);
        if (per_cu < 1) per_cu = 1;
        grid = cus * 1;
        (void)hipGetLastError();
    }
    if (grid < 0) return;
    Args a{};
    for (int i = 0; i < 12; ++i) a.in[i] = (const float*)d_in[i];
    a.out = (float*)d_out; a.ws = (unsigned char*)d_ws;
#if MK_ONE_LAUNCH
    (void)hipMemsetAsync((unsigned char*)d_ws + WS_BAR, 0, 16384, stream);
    a.ph_lo = 0; a.ph_hi = N_PHASES;
    void* kargs[] = {&a};
    hipError_t e = hipLaunchCooperativeKernel((const void*)mk_fwd, dim3(grid), dim3(NTHREADS), kargs, LDS_BYTES, stream);
    if (e != hipSuccess) fprintf(stderr, "cooperative launch failed: %s (grid %d)\n", hipGetErrorString(e), grid);
#else
    for (int p = 0; p < N_PHASES; ++p) {
        a.ph_lo = p; a.ph_hi = p + 1;
        hipLaunchKernelGGL(mk_fwd, dim3(grid), dim3(NTHREADS), LDS_BYTES, stream, a);
    }
#endif
}
```

```cpp
#include <hip/hip_runtime.h>
#include <hip/hip_cooperative_groups.h>
#include <cstdio>
#include <cstdint>
namespace cg = cooperative_groups;

#define LAS __attribute__((address_space(3)))
typedef unsigned short bf16_t;
typedef short bf16x8 __attribute__((ext_vector_type(8)));
typedef float f32x4 __attribute__((ext_vector_type(4)));
typedef float f32x2 __attribute__((ext_vector_type(2)));
typedef unsigned u32x4 __attribute__((ext_vector_type(4)));
typedef unsigned u32x2 __attribute__((ext_vector_type(2)));

constexpr int DM = 1024, DIN = 9216, T_ALL = 49152, RT = 16384, NROUND = 3, NHEAD = 8;
constexpr int NTHREADS = 512, NWAVES = 8;
constexpr float QSCALE = 0.125f * 1.4426950408889634f;
constexpr float LOG2E = 1.4426950408889634f;

constexpr size_t MiB = 1u << 20;
constexpr size_t WS_WIN = 0;
constexpr size_t WS_WA = 18 * MiB;
constexpr size_t WS_WB = 19 * MiB;
constexpr size_t WS_WO = 20 * MiB;
constexpr size_t WS_ROPE = 22 * MiB;
constexpr size_t WS_H = 26 * MiB;
constexpr size_t WS_HL = 122 * MiB;
constexpr size_t HL_BYTES = 16 * MiB;
constexpr size_t WS_SGA = WS_HL + 12 * HL_BYTES;
constexpr size_t WS_SGB = WS_SGA + 16 * MiB;
constexpr size_t WS_SMA = WS_SGB + 16 * MiB;
constexpr size_t WS_SMB = WS_SMA + 32 * MiB;
constexpr size_t WS_OA = WS_SMB + 32 * MiB;
constexpr size_t WS_OB = WS_OA + 16 * MiB;
constexpr size_t WS_GAINS = WS_OB + 16 * MiB;
constexpr size_t WS_BAR = WS_GAINS + 65536;
constexpr size_t WS_MERGED = WS_GAINS + 1 * MiB;
constexpr size_t WS_END = WS_MERGED + 32 * MiB;
constexpr size_t WS_P = WS_HL + 2 * HL_BYTES;
static_assert(WS_END <= 512 * MiB, "ws map");

__constant__ float INV_FREQ[32] = {1.000000000e+00f, 7.498942018e-01f, 5.623413324e-01f, 4.216965139e-01f, 3.162277639e-01f, 2.371373773e-01f, 1.778279394e-01f, 1.333521456e-01f, 1.000000015e-01f, 7.498942316e-02f, 5.623413250e-02f, 4.216964915e-02f, 3.162277490e-02f, 2.371373773e-02f, 1.778279431e-02f, 1.333521400e-02f, 9.999999776e-03f, 7.498942316e-03f, 5.623413250e-03f, 4.216964822e-03f, 3.162277630e-03f, 2.371373819e-03f, 1.778279431e-03f, 1.333521446e-03f, 1.000000047e-03f, 7.498941850e-04f, 5.623413017e-04f, 4.216965172e-04f, 3.162277571e-04f, 2.371373703e-04f, 1.778279402e-04f, 1.333521504e-04f};

typedef __bf16 bf16x2_hw __attribute__((ext_vector_type(2)));
__device__ __forceinline__ unsigned cvt_pk_bf16(float lo, float hi) { const f32x2 v = {lo, hi}; const bf16x2_hw b = __builtin_convertvector(v, bf16x2_hw); return __builtin_bit_cast(unsigned, b); }
__device__ __forceinline__ float bf_lo(unsigned u) { return __uint_as_float(u << 16); }
__device__ __forceinline__ float bf_hi(unsigned u) { return __uint_as_float(u & 0xffff0000u); }
__device__ __forceinline__ float bf2f(bf16_t u) { return __uint_as_float(((unsigned)u) << 16); }
__device__ __forceinline__ float fast_exp2(float x) { return __builtin_amdgcn_exp2f(x); }
__device__ __forceinline__ float sigmoidf_(float x) { return __builtin_amdgcn_rcpf(1.0f + __builtin_amdgcn_exp2f(x * -1.4426950408889634f)); }
__device__ __forceinline__ float xsum16(float x) { const auto r = __builtin_amdgcn_permlane16_swap(__float_as_uint(x), __float_as_uint(x), false, false); return __uint_as_float(r[0]) + __uint_as_float(r[1]); }
__device__ __forceinline__ float xsum32(float x) { const auto r = __builtin_amdgcn_permlane32_swap(__float_as_uint(x), __float_as_uint(x), false, false); return __uint_as_float(r[0]) + __uint_as_float(r[1]); }
__device__ __forceinline__ float xmax16(float x) { const auto r = __builtin_amdgcn_permlane16_swap(__float_as_uint(x), __float_as_uint(x), false, false); return fmaxf(__uint_as_float(r[0]), __uint_as_float(r[1])); }
__device__ __forceinline__ float xmax32(float x) { const auto r = __builtin_amdgcn_permlane32_swap(__float_as_uint(x), __float_as_uint(x), false, false); return fmaxf(__uint_as_float(r[0]), __uint_as_float(r[1])); }
__device__ __forceinline__ int opaque_tid() { int t = threadIdx.x; asm volatile("" : "+v"(t)); return t; }
__device__ __forceinline__ float wave_sum(float v) {
#pragma unroll
    for (int o = 1; o < 64; o <<= 1) v += __shfl_xor(v, o);
    return v;
}

namespace pg8 {
constexpr int BM = 256, BK = 64, HALF = 128, HTB = HALF * BK * 2, STAGE_BYTES = 8 * HTB, NXCD = 8, WGM = 8;
__host__ __device__ __forceinline__ int lds_byte(int r, int c) { const int st = (r >> 4) * 2 + (c >> 5), rr = r & 15, cc = c & 31, ob = rr * 64 + cc * 2; return st * 1024 + (ob ^ (((ob >> 9) & 1) << 5)); }
__host__ __device__ __forceinline__ void stage_rc(int b, int& R, int& C) { const int st = b / 1024, sb = b % 1024, swz = sb ^ (((sb >> 9) & 1) << 5); R = (st >> 1) * 16 + swz / 64; C = (st & 1) * 32 + (swz % 64) / 2; }
__host__ __device__ __forceinline__ int perm32(int rho) { const int n = rho >> 4, i = rho & 15; return 8 * (i >> 2) + 4 * n + (i & 3); }

struct Unit { int pm, pn, br, rk; };

__device__ __forceinline__ void tile_of(int L, int nM, int nN, int& pm, int& pn) {
    const int nwg = nM * nN; int wgid = L;
    { const int q = nwg / NXCD, r = nwg % NXCD, xcd = wgid % NXCD, off = wgid / NXCD; wgid = (xcd < r ? xcd * (q + 1) : r * (q + 1) + (xcd - r) * q) + off; }
    const int nig = WGM * nN, gid = wgid / nig, fm = gid * WGM, gsz = (nM - fm) < WGM ? (nM - fm) : WGM;
    pm = fm + ((wgid % nig) % gsz); pn = (wgid % nig) / gsz;
}

template <int K, class Epi, class Sched>
__device__ __forceinline__ void gemm_phase(LAS unsigned char* lds, const Sched& S, const Epi& E) {
    int tid_ = threadIdx.x; asm volatile("" : "+v"(tid_));
    const int tid = tid_, wid = __builtin_amdgcn_readfirstlane(tid >> 6), lane = tid & 63, wr = wid >> 2, wc = wid & 3, fr = lane & 15, fq = lane >> 4;
    const int nt = K / BK;
    unsigned voffA[2], voffB[2];
#pragma unroll
    for (int i = 0; i < 2; ++i) { int R, C; stage_rc(tid * 16 + i * 8192, R, C); const int Rb = 64 * (R >> 5) + perm32(R & 31);
        voffA[i] = (unsigned)(R * K + C) * 2u; voffB[i] = (unsigned)(Rb * K + C) * 2u; }
    const size_t kstep = (size_t)(BK * 2);
    const size_t hstep = (size_t)HALF * K * 2;
    const size_t hstepB = (size_t)32 * K * 2;
    const unsigned ldsw = (unsigned)wid * 1024u;
    const int aoff = lds_byte(wr * 64 + fr, fq * 8), boff = lds_byte(wc * 32 + fr, fq * 8);
#define PG8_SA(b, h) (((b) * 2 + (h)) * HTB)
#define PG8_SB(b, h) ((4 + (b) * 2 + (h)) * HTB)
#define PG8_STAGE(bufoff, gbase, voff) do { _Pragma("unroll") for (int _i = 0; _i < 2; ++_i) \
        __builtin_amdgcn_global_load_lds((const unsigned*)((const char*)(gbase) + (voff)[_i]), (LAS unsigned*)(lds + (bufoff) + ldsw + _i * 8192), 16, 0, 0); } while (0)
#define PG8_LDA(dst, b, h) do { _Pragma("unroll") for (int m = 0; m < 4; ++m) _Pragma("unroll") for (int k = 0; k < 2; ++k) dst[m][k] = *(const LAS bf16x8*)(lds + PG8_SA(b, h) + aoff + m * 2048 + k * 1024); } while (0)
#define PG8_LDB(dst, b, h) do { _Pragma("unroll") for (int n = 0; n < 2; ++n) _Pragma("unroll") for (int k = 0; k < 2; ++k) dst[n][k] = *(const LAS bf16x8*)(lds + PG8_SB(b, h) + boff + n * 2048 + k * 1024); } while (0)
#define PG8_MMA(ai, bj, At, Bt) do { __builtin_amdgcn_s_setprio(1); _Pragma("unroll") for (int m = 0; m < 4; ++m) _Pragma("unroll") for (int n = 0; n < 2; ++n) _Pragma("unroll") for (int k = 0; k < 2; ++k) \
        acc[ai][bj][m][n] = __builtin_amdgcn_mfma_f32_16x16x32_bf16(Bt[n][k], At[m][k], acc[ai][bj][m][n], 0, 0, 0); __builtin_amdgcn_s_setprio(0); } while (0)
#define PG8_WAIT_V(n) asm volatile("s_waitcnt vmcnt(" #n ")" ::: "memory")
#define PG8_WAIT_L(n) asm volatile("s_waitcnt lgkmcnt(" #n ")" ::: "memory")
#define PG8_BAR __builtin_amdgcn_s_barrier()
#define PG8_SCHED __builtin_amdgcn_sched_barrier(0)
    Unit cur, nxt; int ui = 0;
    if (!S.next(0, cur)) return;
    f32x4 acc[2][2][4][2];
#pragma unroll
    for (int a = 0; a < 2; ++a)
#pragma unroll
        for (int b = 0; b < 2; ++b)
#pragma unroll
            for (int m = 0; m < 4; ++m)
#pragma unroll
                for (int n = 0; n < 2; ++n) acc[a][b][m][n] = (f32x4){0.f, 0.f, 0.f, 0.f};
    bf16x8 At[4][2], B0[2][2], B1[2][2];
    const char* cA = S.a_ptr(cur); const char* cB = S.b_ptr(cur);
    int rk = cur.rk;
    { const char* pA = cA + (size_t)rk * kstep; const char* pB = cB + (size_t)rk * kstep;
    PG8_STAGE(PG8_SB(0, 0), pB, voffB); PG8_STAGE(PG8_SB(0, 1), pB + hstepB, voffB); PG8_STAGE(PG8_SA(0, 0), pA, voffA); PG8_STAGE(PG8_SA(0, 1), pA + hstep, voffA);
    if (wr == 1) PG8_BAR;
    PG8_WAIT_V(2); PG8_BAR;
    PG8_STAGE(PG8_SB(1, 0), pB + kstep, voffB); PG8_STAGE(PG8_SA(1, 0), pA + kstep, voffA); PG8_STAGE(PG8_SB(1, 1), pB + hstepB + kstep, voffB); }
    PG8_WAIT_V(6); PG8_BAR;
    for (;;) {
        const bool has_next = S.next(ui + 1, nxt);
        const char* nA = has_next ? S.a_ptr(nxt) : cA; const char* nB = has_next ? S.b_ptr(nxt) : cB; const int nrk = has_next ? nxt.rk : rk;
        for (int t = 0; t < nt; t += 2) {
            const bool last = (t == nt - 2);
            const char* a1 = cA + (size_t)((t + 1 + rk) & (nt - 1)) * kstep;
            const char* a2 = last ? nA + (size_t)nrk * kstep : cA + (size_t)((t + 2 + rk) & (nt - 1)) * kstep; const char* b2 = last ? nB + (size_t)nrk * kstep : cB + (size_t)((t + 2 + rk) & (nt - 1)) * kstep;
            const char* a3 = a2 + kstep; const char* b3 = b2 + kstep;
            if constexpr (Epi::MIDK) { if (t == nt / 2) { int z_ = t - nt / 2; asm volatile("" : "+v"(z_)); E.mid(acc, cur, wr, wc, fr + z_, fq); } }
            PG8_LDB(B0, 0, 0); PG8_LDB(B1, 0, 1); PG8_SCHED; PG8_LDA(At, 0, 0); PG8_STAGE(PG8_SA(1, 1), a1 + hstep, voffA);
            PG8_WAIT_V(8); PG8_WAIT_L(0); PG8_BAR; PG8_MMA(0, 0, At, B0); PG8_MMA(0, 1, At, B1); PG8_BAR; PG8_SCHED;
            PG8_LDA(At, 0, 1); PG8_STAGE(PG8_SB(0, 0), b2, voffB); PG8_STAGE(PG8_SB(0, 1), b2 + hstepB, voffB); PG8_STAGE(PG8_SA(0, 0), a2, voffA);
            PG8_WAIT_V(8); PG8_WAIT_L(0); PG8_BAR; PG8_MMA(1, 0, At, B0); PG8_MMA(1, 1, At, B1); PG8_BAR; PG8_SCHED;
            PG8_LDB(B0, 1, 0); PG8_LDB(B1, 1, 1); PG8_SCHED; PG8_LDA(At, 1, 0); PG8_STAGE(PG8_SA(0, 1), a2 + hstep, voffA);
            PG8_WAIT_V(8); PG8_WAIT_L(0); PG8_BAR; PG8_MMA(0, 0, At, B0); PG8_MMA(0, 1, At, B1); PG8_BAR; PG8_SCHED;
            PG8_LDA(At, 1, 1); PG8_STAGE(PG8_SB(1, 0), b3, voffB); PG8_STAGE(PG8_SB(1, 1), b3 + hstepB, voffB); PG8_STAGE(PG8_SA(1, 0), a3, voffA);
            PG8_WAIT_V(8); PG8_WAIT_L(0); PG8_BAR; PG8_MMA(1, 0, At, B0); PG8_MMA(1, 1, At, B1); PG8_BAR; PG8_SCHED;
        }
        if (wr == 0) PG8_BAR;
        E.fin(acc, cur, wr, wc, fr, fq);
        if (!has_next) break;
#pragma unroll
        for (int a = 0; a < 2; ++a)
#pragma unroll
            for (int b = 0; b < 2; ++b)
#pragma unroll
                for (int m = 0; m < 4; ++m)
#pragma unroll
                    for (int n = 0; n < 2; ++n) acc[a][b][m][n] = (f32x4){0.f, 0.f, 0.f, 0.f};
        cur = nxt; cA = nA; cB = nB; rk = nrk; ++ui;
        if (wr == 1) PG8_BAR;
    }
    PG8_WAIT_V(0);
    PG8_BAR;
#undef PG8_SA
#undef PG8_SB
#undef PG8_STAGE
#undef PG8_LDA
#undef PG8_LDB
#undef PG8_MMA
#undef PG8_WAIT_V
#undef PG8_WAIT_L
#undef PG8_BAR
#undef PG8_SCHED
}
}
using pg8::Unit;

__device__ __forceinline__ int perm_row(int ml, int lgL, int ld) {
    const int L = 1 << lgL, t = ml & (L - 1), sb = ml - t;
    return sb + ((t & ((1 << ld) - 1)) << (lgL - ld)) + (t >> ld);
}

constexpr int EPI_LDS_OFF = 131072 + 256, EPI_SLICE = 16 * 144;
__device__ __forceinline__ void epi_rows(LAS unsigned char* sl, int fr, int fq, const u32x4& w0, const u32x4& w1, u32x4& r0, u32x4& r1) {
    *(LAS u32x4*)(sl + fr * 144 + fq * 16) = w0; *(LAS u32x4*)(sl + fr * 144 + 64 + fq * 16) = w1;
    const int lane = fr + 16 * fq, row = lane >> 3, part = lane & 7;
    r0 = *(const LAS u32x4*)(sl + row * 144 + part * 16); r1 = *(const LAS u32x4*)(sl + (row + 8) * 144 + part * 16);
}

__device__ __forceinline__ void rows_to_lane(LAS unsigned char* sl, int lane, int fr, int a0, int a1, const u32x4& r0, const u32x4& r1, u32x4& p0, u32x4& p1) {
    const int row = lane >> 3, part = lane & 7;
    *(LAS u32x4*)(sl + row * 144 + part * 16) = r0; *(LAS u32x4*)(sl + (row + 8) * 144 + part * 16) = r1;
    p0 = *(const LAS u32x4*)(sl + fr * 144 + a0 * 16); p1 = *(const LAS u32x4*)(sl + fr * 144 + a1 * 16);
}
__device__ __forceinline__ void lane_to_rows(LAS unsigned char* sl, int lane, int fr, int a0, int a1, const u32x4& p0, const u32x4& p1, u32x4& r0, u32x4& r1) {
    const int row = lane >> 3, part = lane & 7;
    *(LAS u32x4*)(sl + fr * 144 + a0 * 16) = p0; *(LAS u32x4*)(sl + fr * 144 + a1 * 16) = p1;
    r0 = *(const LAS u32x4*)(sl + row * 144 + part * 16); r1 = *(const LAS u32x4*)(sl + (row + 8) * 144 + part * 16);
}

struct EpiG1 {
    static constexpr bool MIDK = false;
    unsigned char* ws; int lgL; LAS unsigned char* lds_epi;
    __device__ __forceinline__ void fin(const f32x4 (&acc)[2][2][4][2], const Unit& u, int wr, int wc, int fr, int fq) const {
        const int cb = u.pn >> 1, half = u.pn & 1;
        const int rowb = u.pm * 256 + wr * 64 + fr;
        LAS unsigned char* sl = lds_epi + (wr * 4 + wc) * EPI_SLICE;
        const int lane_ = fr + 16 * fq, srow = lane_ >> 3, spart = lane_ & 7, rowb0 = u.pm * 256 + wr * 64;
        if (cb == 3 || cb >= 13) {
            bf16_t* dst; int ld_, colb; bool sig;
            if (cb == 3) { dst = (bf16_t*)(ws + WS_SGA); ld_ = 512; colb = half * 256; sig = false; }
            else if (cb == 13) { dst = (bf16_t*)(ws + WS_SGB); ld_ = 512; colb = half * 256; sig = false; }
            else if (cb < 16) { dst = (bf16_t*)(ws + WS_SMA); ld_ = 1024; colb = (u.pn - 28) * 256; sig = true; }
            else { dst = (bf16_t*)(ws + WS_SMB); ld_ = 1024; colb = (u.pn - 32) * 256; sig = true; }
#pragma unroll
            for (int ai = 0; ai < 2; ++ai)
#pragma unroll
                for (int m = 0; m < 4; ++m) {
                    float x[16], t[16];
#pragma unroll
                    for (int bj = 0; bj < 2; ++bj)
#pragma unroll
                        for (int n = 0; n < 2; ++n)
#pragma unroll
                            for (int e = 0; e < 4; ++e) x[8 * bj + 4 * n + e] = acc[ai][bj][m][n][e];
#pragma unroll
                    for (int j = 0; j < 16; ++j) t[j] = x[j] * -1.4426950408889634f;
#pragma unroll
                    for (int j = 0; j < 16; ++j) t[j] = __builtin_amdgcn_exp2f(t[j]);
#pragma unroll
                    for (int j = 0; j < 16; ++j) t[j] = 1.0f + t[j];
#pragma unroll
                    for (int j = 0; j < 16; ++j) t[j] = __builtin_amdgcn_rcpf(t[j]);
                    if (!sig) {
#pragma unroll
                        for (int j = 0; j < 16; ++j) t[j] = x[j] * t[j];
                    }
                    u32x4 w[2], r0, r1;
#pragma unroll
                    for (int bj = 0; bj < 2; ++bj) { w[bj].x = cvt_pk_bf16(t[8 * bj + 0], t[8 * bj + 1]); w[bj].y = cvt_pk_bf16(t[8 * bj + 2], t[8 * bj + 3]); w[bj].z = cvt_pk_bf16(t[8 * bj + 4], t[8 * bj + 5]); w[bj].w = cvt_pk_bf16(t[8 * bj + 6], t[8 * bj + 7]); }
                    if (sig) {
                        bf16_t* gp = dst + ((((size_t)(u.pm * 4 + (colb >> 8)) * 8 + (wr * 4 + wc)) * 2 + ai) * 4 + m) * 1024 + lane_ * 8;
                        *(u32x4*)gp = w[0]; *(u32x4*)(gp + 512) = w[1];
                    } else {
                        epi_rows(sl, fr, fq, w[0], w[1], r0, r1);
                        bf16_t* rp0 = dst + (size_t)(rowb0 + ai * 128 + m * 16 + srow) * ld_ + colb + wc * 64 + spart * 8;
                        *(u32x4*)rp0 = r0; *(u32x4*)(rp0 + (size_t)8 * ld_) = r1;
                    }
                }
            return;
        }
        const int hl = cb < 3 ? cb : cb - 1;
        const int typ = cb < 3 ? cb : (cb - 4) % 3;
        const int grp = cb < 3 ? -1 : (cb - 4) / 3;
        const int ld = grp < 0 ? 0 : 2 * grp;
        const int head = 4 * half + wc;
        bf16_t* dst = (bf16_t*)(ws + WS_HL + (size_t)hl * HL_BYTES) + (size_t)head * RT * 64 + 8 * spart;
        float gn[2][8];
        if (typ < 2) {
            const float* g = (const float*)(ws + WS_GAINS) + ((grp < 0 ? 0 : 2) + typ) * 64;
            const float sc = typ == 0 ? QSCALE : 1.0f;
#pragma unroll
            for (int bj = 0; bj < 2; ++bj)
#pragma unroll
                for (int j = 0; j < 8; ++j) gn[bj][j] = g[32 * bj + 8 * fq + j] * sc;
        }
        const float* rope = (const float*)(ws + WS_ROPE);
        const int Lm = (1 << lgL) - 1;
#pragma unroll
        for (int ai = 0; ai < 2; ++ai)
#pragma unroll
            for (int m = 0; m < 4; ++m) {
                const int ml = rowb + ai * 128 + m * 16;
                float v[2][8];
#pragma unroll
                for (int bj = 0; bj < 2; ++bj)
#pragma unroll
                    for (int n = 0; n < 2; ++n)
#pragma unroll
                        for (int e = 0; e < 4; ++e) v[bj][4 * n + e] = acc[ai][bj][m][n][e];
                if (typ < 2) {
                    float ss = 0.f;
#pragma unroll
                    for (int bj = 0; bj < 2; ++bj)
#pragma unroll
                        for (int j = 0; j < 8; ++j) ss += v[bj][j] * v[bj][j];
                    ss = xsum16(ss); ss = xsum32(ss);
                    const float rs = __builtin_amdgcn_rsqf(ss * (1.0f / 64.0f) + 1e-6f);
#pragma unroll
                    for (int bj = 0; bj < 2; ++bj)
#pragma unroll
                        for (int j = 0; j < 8; ++j) v[bj][j] = v[bj][j] * rs * gn[bj][j];
                    if (grp >= 0) {
                        const float* rp = rope + (size_t)((ml & Lm) >> 4) * 1024 + (size_t)(fr + 16 * fq) * 4;
                        const f32x4 c0 = *(const f32x4*)(rp), c1 = *(const f32x4*)(rp + 256), s0 = *(const f32x4*)(rp + 512), s1 = *(const f32x4*)(rp + 768);
#pragma unroll
                        for (int j = 0; j < 8; ++j) {
                            const float c = j < 4 ? c0[j & 3] : c1[j & 3], s = j < 4 ? s0[j & 3] : s1[j & 3];
                            const float x1 = v[0][j], x2 = v[1][j];
                            v[0][j] = x1 * c - x2 * s; v[1][j] = x2 * c + x1 * s;
                        }
                    }
                }
                u32x4 w[2], r0, r1;
#pragma unroll
                for (int bj = 0; bj < 2; ++bj) { w[bj].x = cvt_pk_bf16(v[bj][0], v[bj][1]); w[bj].y = cvt_pk_bf16(v[bj][2], v[bj][3]); w[bj].z = cvt_pk_bf16(v[bj][4], v[bj][5]); w[bj].w = cvt_pk_bf16(v[bj][6], v[bj][7]); }
                epi_rows(sl, fr, fq, w[0], w[1], r0, r1);
                const int mls = rowb0 + ai * 128 + m * 16 + srow;
                *(u32x4*)(dst + (size_t)perm_row(mls, lgL, ld) * 64) = r0;
                *(u32x4*)(dst + (size_t)perm_row(mls + 8, lgL, ld) * 64) = r1;
                asm volatile("" ::: "memory");
            }
    }
};

struct EpiG2 {
    static constexpr bool MIDK = true;
    unsigned char* ws; LAS unsigned char* lds_epi;
    __device__ __forceinline__ void mid(f32x4 (&acc)[2][2][4][2], const Unit& u, int wr, int wc, int fr, int fq) const {
        const bf16_t* ga = (const bf16_t*)(ws + WS_SMA); const bf16_t* gb = (const bf16_t*)(ws + WS_SMB);
        const int frr = fr & 15, lane = frr + 16 * fq;
        const size_t base = ((size_t)(u.pm * 4 + u.pn) * 8 + (wr * 4 + wc)) * (2 * 4 * 1024) + (size_t)(lane + (fr - frr)) * 8;
#pragma unroll
        for (int ai = 0; ai < 2; ++ai) {
            u32x4 xa[4][2], xb[4][2];
#pragma unroll
            for (int m = 0; m < 4; ++m)
#pragma unroll
                for (int bj = 0; bj < 2; ++bj) { const size_t off = base + (size_t)((ai * 4 + m) * 2 + bj) * 512; xa[m][bj] = *(const u32x4*)(ga + off); xb[m][bj] = *(const u32x4*)(gb + off); }
#pragma unroll
            for (int m = 0; m < 4; ++m)
#pragma unroll
                for (int bj = 0; bj < 2; ++bj) {
                    const u32x4 x = xa[m][bj], y = xb[m][bj];
                    acc[ai][bj][m][0][0] *= bf_lo(x.x) * __builtin_amdgcn_rcpf(bf_lo(y.x)); acc[ai][bj][m][0][1] *= bf_hi(x.x) * __builtin_amdgcn_rcpf(bf_hi(y.x));
                    acc[ai][bj][m][0][2] *= bf_lo(x.y) * __builtin_amdgcn_rcpf(bf_lo(y.y)); acc[ai][bj][m][0][3] *= bf_hi(x.y) * __builtin_amdgcn_rcpf(bf_hi(y.y));
                    acc[ai][bj][m][1][0] *= bf_lo(x.z) * __builtin_amdgcn_rcpf(bf_lo(y.z)); acc[ai][bj][m][1][1] *= bf_hi(x.z) * __builtin_amdgcn_rcpf(bf_hi(y.z));
                    acc[ai][bj][m][1][2] *= bf_lo(x.w) * __builtin_amdgcn_rcpf(bf_lo(y.w)); acc[ai][bj][m][1][3] *= bf_hi(x.w) * __builtin_amdgcn_rcpf(bf_hi(y.w));
                }
            asm volatile("" ::: "memory");
        }
    }
    __device__ __forceinline__ void fin(const f32x4 (&acc)[2][2][4][2], const Unit& u, int wr, int wc, int fr, int fq) const {
        const bf16_t* gb = (const bf16_t*)(ws + WS_SMB); bf16_t* Mg = (bf16_t*)(ws + WS_MERGED);
        LAS unsigned char* sl = lds_epi + (wr * 4 + wc) * EPI_SLICE;
        const int lane = fr + 16 * fq, srow = lane >> 3, spart = lane & 7;
        const size_t base = (size_t)(u.pm * 256 + wr * 64 + srow) * 1024 + u.pn * 256 + wc * 64 + spart * 8;
        const size_t gbase = ((size_t)(u.pm * 4 + u.pn) * 8 + (wr * 4 + wc)) * (2 * 4 * 1024) + (size_t)lane * 8;
#pragma unroll
        for (int ai = 0; ai < 2; ++ai) {
            u32x4 rb[4][2];
#pragma unroll
            for (int m = 0; m < 4; ++m)
#pragma unroll
                for (int bj = 0; bj < 2; ++bj) rb[m][bj] = *(const u32x4*)(gb + gbase + (size_t)((ai * 4 + m) * 2 + bj) * 512);
#pragma unroll
            for (int m = 0; m < 4; ++m) {
                u32x4 w[2], r0, r1;
#pragma unroll
                for (int bj = 0; bj < 2; ++bj) {
                    const u32x4 y = rb[m][bj]; const f32x4 a0 = acc[ai][bj][m][0], a1 = acc[ai][bj][m][1];
                    w[bj].x = cvt_pk_bf16(a0[0] * bf_lo(y.x), a0[1] * bf_hi(y.x)); w[bj].y = cvt_pk_bf16(a0[2] * bf_lo(y.y), a0[3] * bf_hi(y.y));
                    w[bj].z = cvt_pk_bf16(a1[0] * bf_lo(y.z), a1[1] * bf_hi(y.z)); w[bj].w = cvt_pk_bf16(a1[2] * bf_lo(y.w), a1[3] * bf_hi(y.w));
                }
                lane_to_rows(sl, lane, fr, fq, 4 + fq, w[0], w[1], r0, r1);
                bf16_t* op = Mg + base + (size_t)(ai * 128 + m * 16) * 1024;
                *(u32x4*)op = r0; *(u32x4*)(op + 8 * 1024) = r1;
            }
            asm volatile("" ::: "memory");
        }
    }
};

struct EpiG3 {
    static constexpr bool MIDK = false;
    const float* x; float* out; LAS unsigned char* lds_epi;
    __device__ __forceinline__ void fin(const f32x4 (&acc)[2][2][4][2], const Unit& u, int wr, int wc, int fr, int fq) const {
        LAS unsigned char* sl = lds_epi + (wr * 4 + wc) * EPI_SLICE;
        const int lane = fr + 16 * fq, srow = lane >> 3, spart = lane & 7;
        const size_t base = (size_t)(u.pm * 256 + wr * 64 + srow) * 1024 + u.pn * 256 + wc * 64 + spart * 4;
#pragma unroll
        for (int ai = 0; ai < 2; ++ai)
#pragma unroll
            for (int mh = 0; mh < 2; ++mh) {
                u32x4 rx[2][2][2];
#pragma unroll
                for (int mm = 0; mm < 2; ++mm)
#pragma unroll
                    for (int bj = 0; bj < 2; ++bj)
#pragma unroll
                        for (int i = 0; i < 2; ++i) rx[mm][bj][i] = *(const u32x4*)(x + base + (size_t)(ai * 128 + (2 * mh + mm) * 16 + 8 * i) * 1024 + bj * 32);
#pragma unroll
                for (int mm = 0; mm < 2; ++mm)
#pragma unroll
                    for (int bj = 0; bj < 2; ++bj) {
                        const int m = 2 * mh + mm; u32x4 p0, p1, r0, r1;
                        rows_to_lane(sl, lane, fr, 2 * fq, 2 * fq + 1, rx[mm][bj][0], rx[mm][bj][1], p0, p1);
                        const f32x4 o0 = __builtin_bit_cast(f32x4, p0) + acc[ai][bj][m][0], o1 = __builtin_bit_cast(f32x4, p1) + acc[ai][bj][m][1];
                        lane_to_rows(sl, lane, fr, 2 * fq, 2 * fq + 1, __builtin_bit_cast(u32x4, o0), __builtin_bit_cast(u32x4, o1), r0, r1);
                        float* op = out + base + (size_t)(ai * 128 + m * 16) * 1024 + bj * 32;
                        *(u32x4*)op = r0; *(u32x4*)(op + 8 * 1024) = r1;
                    }
                asm volatile("" ::: "memory");
            }
    }
};

struct SchedX {
    const char* ws; size_t offH; int hk, pn_lo, n_pn, G, c;
    __device__ __forceinline__ bool next(int i, Unit& u) const {
        int L = i * G + c;
        if (hk > 0) {
            if (G == 256) {
                const int ng = (64 * n_pn) / 256, hp = (((c >> 3) & 7) * ng) / 7;
                if (i == hp) { pg8::tile_of(c, 64, 4, u.pm, u.pn); u.br = hk; u.rk = hk == 1 ? 0 : 2 * ((u.pm >> 3) & 7); return true; }
                const int j = i < hp ? i : i - 1;
                if (j >= ng) return false;
                L = j * 256 + c;
            } else {
                if (L < 256) { pg8::tile_of(L, 64, 4, u.pm, u.pn); u.br = hk; u.rk = 0; return true; }
                L -= 256;
            }
        }
        if (L >= 64 * n_pn) return false;
        int pnl; pg8::tile_of(L, 64, n_pn, u.pm, pnl);
        pnl += 4 * (((u.pm >> 3) * (n_pn >> 2)) >> 3); if (pnl >= n_pn) pnl -= n_pn;
        u.pn = pn_lo + pnl; u.br = 0; u.rk = 2 * ((u.pm >> 3) & 7); return true;
    }
    __device__ __forceinline__ const char* a_ptr(const Unit& u) const { const size_t off = u.br == 0 ? offH : (u.br == 1 ? WS_OA : WS_MERGED); return ws + off + (size_t)u.pm * (256 * 1024 * 2); }
    __device__ __forceinline__ const char* b_ptr(const Unit& u) const { const size_t off = u.br == 0 ? WS_WIN : (u.br == 1 ? WS_WA : WS_WO); return ws + off + (size_t)u.pn * (256 * 1024 * 2); }
};
struct EpiX {
    static constexpr bool MIDK = true;
    EpiG1 e1; EpiG2 e2; EpiG3 e3;
    __device__ __forceinline__ void mid(f32x4 (&acc)[2][2][4][2], const Unit& u, int wr, int wc, int fr, int fq) const { if (u.br == 1) e2.mid(acc, u, wr, wc, fr, fq); }
    __device__ __forceinline__ void fin(const f32x4 (&acc)[2][2][4][2], const Unit& u, int wr, int wc, int fr, int fq) const {
        if (u.br == 0) e1.fin(acc, u, wr, wc, fr, fq); else if (u.br == 1) e2.fin(acc, u, wr, wc, fr, fq); else e3.fin(acc, u, wr, wc, fr, fq);
    }
};

__device__ __forceinline__ void p0_transpose_item(const float* W, int K, int N, bf16_t* WT, int ldw, LAS float* scr, int item, int lane) {
    const int nblk = N / 32, kb = item / nblk, nb = item % nblk, k0 = 64 * kb, n0 = 32 * nb;
    float wv[32];
#pragma unroll
    for (int i = 0; i < 32; ++i) wv[i] = W[(size_t)(k0 + 2 * i + (lane >> 5)) * N + n0 + (lane & 31)];
#pragma unroll
    for (int i = 0; i < 32; ++i) scr[(2 * i + (lane >> 5)) * 33 + (lane & 31)] = wv[i];
    asm volatile("s_waitcnt lgkmcnt(0)" ::: "memory");
    const int c = lane & 7;
#pragma unroll
    for (int j = 0; j < 4; ++j) { const int n = (lane >> 3) + 8 * j; const LAS float* s = scr + (8 * c) * 33 + n;
        u32x4 o; o.x = cvt_pk_bf16(s[0 * 33], s[1 * 33]); o.y = cvt_pk_bf16(s[2 * 33], s[3 * 33]); o.z = cvt_pk_bf16(s[4 * 33], s[5 * 33]); o.w = cvt_pk_bf16(s[6 * 33], s[7 * 33]);
        *(u32x4*)(WT + (size_t)(n0 + n) * ldw + k0 + 8 * c) = o; }
    asm volatile("s_waitcnt lgkmcnt(0)" ::: "memory");
}

__device__ __forceinline__ void sincos_d(double x, float& s, float& c) {
    const double n = rint(x * 0.15915494309189535);
    double r = fma(-n, 6.283185307179586, x); r = fma(-n, 2.4492935982947064e-16, r);
    const double r2 = r * r;
    double ts = r, tc = 1.0, ss = r, cc = 1.0;
#pragma unroll
    for (int k = 1; k <= 14; ++k) {
        tc *= -r2 * (1.0 / (double)((2 * k - 1) * (2 * k))); cc += tc;
        ts *= -r2 * (1.0 / (double)((2 * k) * (2 * k + 1))); ss += ts;
    }
    s = (float)ss; c = (float)cc;
}

struct Args { const float* in[12]; float* out; unsigned char* ws; int ph_lo, ph_hi; };

__device__ __forceinline__ const float* x_row(const Args& a, int m) { return m < 32768 ? a.in[0] + (size_t)m * DM : a.in[1] + (size_t)(m - 32768) * DM; }

__device__ __forceinline__ void p0_prologue(const Args& a, LAS unsigned char* lds, int G) {
    const int tid = opaque_tid(), lane = tid & 63, wave = tid >> 6;
    LAS float* scr = (LAS float*)(lds + wave * 16384);
    const int gw = blockIdx.x * NWAVES + wave, NGW = G * NWAVES;
    constexpr int I_IN = 16 * 288, I_A = 8 * 32, I_O = 16 * 32;
    for (int it = gw; it < I_IN + 2 * I_A + I_O; it += NGW) {
        int r = it;
        if (r < I_IN) { p0_transpose_item(a.in[3], 1024, DIN, (bf16_t*)(a.ws + WS_WIN), 1024, scr, r, lane); continue; } r -= I_IN;
        if (r < I_A) { p0_transpose_item(a.in[9], 512, 1024, (bf16_t*)(a.ws + WS_WA), 1024, scr, r, lane); continue; } r -= I_A;
        if (r < I_A) { p0_transpose_item(a.in[10], 512, 1024, (bf16_t*)(a.ws + WS_WA) + 512, 1024, scr, r, lane); continue; } r -= I_A;
        p0_transpose_item(a.in[11], 1024, 1024, (bf16_t*)(a.ws + WS_WO), 1024, scr, r, lane);
    }
    if (blockIdx.x == 0 && tid < 64) {
        float* gt = (float*)(a.ws + WS_GAINS);
        gt[tid] = a.in[4][tid]; gt[64 + tid] = a.in[5][tid]; gt[128 + tid] = a.in[7][tid]; gt[192 + tid] = a.in[8][tid];
    }
    float* rope = (float*)(a.ws + WS_ROPE);
    for (int i = blockIdx.x * NTHREADS + tid; i < 16384 * 32; i += G * NTHREADS) {
        const int t = i >> 5, f = i & 31; const float ang = (float)t * INV_FREQ[f];
        float s, c; sincos_d((double)ang, s, c);
        { const size_t b = (size_t)(t >> 4) * 1024 + (size_t)(((f >> 2) & 1) * 256) + (size_t)((t & 15) + 16 * (f >> 3)) * 4 + (f & 3); rope[b] = c; rope[b + 512] = s; }
    }
    const float* gain = a.in[2];
    f32x4 gv[4];
#pragma unroll
    for (int j = 0; j < 4; ++j) gv[j] = *(const f32x4*)(gain + 4 * lane + 256 * j);
    bf16_t* H = (bf16_t*)(a.ws + WS_H);
    for (int m0 = gw * 8; m0 < RT; m0 += NGW * 8) {
        f32x4 v[8][4]; float s[8];
#pragma unroll
        for (int rr = 0; rr < 8; ++rr) { const f32x4* xr = (const f32x4*)x_row(a, m0 + rr) + lane;
#pragma unroll
            for (int j = 0; j < 4; ++j) v[rr][j] = xr[64 * j]; }
#pragma unroll
        for (int rr = 0; rr < 8; ++rr) { float t = 0.f;
#pragma unroll
            for (int j = 0; j < 4; ++j) t += (v[rr][j].x * v[rr][j].x + v[rr][j].y * v[rr][j].y) + (v[rr][j].z * v[rr][j].z + v[rr][j].w * v[rr][j].w);
            s[rr] = t; }
#pragma unroll
        for (int o = 1; o < 64; o <<= 1) {
#pragma unroll
            for (int rr = 0; rr < 8; ++rr) s[rr] += __shfl_xor(s[rr], o);
        }
#pragma unroll
        for (int rr = 0; rr < 8; ++rr) {
            const float rstd = 1.0f / sqrtf(s[rr] * (1.0f / DM) + 1e-6f);
            u32x2* o8 = (u32x2*)(H + (size_t)(m0 + rr) * DM) + lane;
#pragma unroll
            for (int j = 0; j < 4; ++j) { u32x2 w; w.x = cvt_pk_bf16(v[rr][j].x * rstd * gv[j].x, v[rr][j].y * rstd * gv[j].y); w.y = cvt_pk_bf16(v[rr][j].z * rstd * gv[j].z, v[rr][j].w * rstd * gv[j].w); o8[64 * j] = w; }
        }
    }
}

typedef short v4i16_t __attribute__((ext_vector_type(4)));
constexpr int ATT_O_OFF = 0;
constexpr int ATT_LSE_OFF = 65536;
constexpr int ATT_BIAS_OFF = 67584;
constexpr int ATT_NEG_OFF = 82464;
constexpr int ATT_VSCR_OFF = 83968;
constexpr int VROW = 160;

template <int NQT, int NKT, int KB, class KF_t, class MF_t>
__device__ __forceinline__ void attn_core(const bf16_t* qbase, const KF_t& KF, const MF_t& MF, LAS unsigned char* vscr, int lane,
                                          f32x4 (&o)[NQT][4], float (&mx)[NQT], float (&l)[NQT]) {
    const int fr = lane & 15, fq = lane >> 4;
    constexpr int NB = NKT / KB;
    const int vrow = (lane >> 3), vpart = lane & 7;
    bf16x8 qf[NQT][2];
    {
        u32x4 qr[NQT][2];
#pragma unroll
        for (int qt = 0; qt < NQT; ++qt)
#pragma unroll
            for (int i = 0; i < 2; ++i) qr[qt][i] = *(const u32x4*)(qbase + (size_t)(16 * qt + vrow + 8 * i) * 64 + vpart * 8);
#pragma unroll
        for (int qt = 0; qt < NQT; ++qt)
#pragma unroll
            for (int i = 0; i < 2; ++i) *(LAS u32x4*)(vscr + (16 * qt + vrow + 8 * i) * VROW + vpart * 16) = qr[qt][i];
#pragma unroll
        for (int qt = 0; qt < NQT; ++qt)
#pragma unroll
            for (int ks = 0; ks < 2; ++ks) qf[qt][ks] = *(const LAS bf16x8*)(vscr + (16 * qt + fr) * VROW + ks * 64 + fq * 16);
    }
    u32x4 kr[NKT / 2][4];
#pragma unroll
    for (int kb = 0; kb < NKT / 2; ++kb)
#pragma unroll
        for (int i = 0; i < 4; ++i) kr[kb][i] = *(const u32x4*)(KF.kptr(2 * kb + (i >> 1)) + ((vrow + 8 * i) & 15) * 64 + vpart * 8);
    __builtin_amdgcn_sched_barrier(0);
    f32x4 s[NQT][NKT];
#pragma unroll
    for (int kb = 0; kb < NKT / 2; ++kb) {
#pragma unroll
        for (int i = 0; i < 4; ++i) *(LAS u32x4*)(vscr + (vrow + 8 * i) * VROW + vpart * 16) = kr[kb][i];
#pragma unroll
        for (int tt = 0; tt < 2; ++tt) {
            const int t = 2 * kb + tt;
            const bf16x8 k0 = *(const LAS bf16x8*)(vscr + (16 * tt + fr) * VROW + fq * 16), k1 = *(const LAS bf16x8*)(vscr + (16 * tt + fr) * VROW + 64 + fq * 16);
#pragma unroll
            for (int qt = 0; qt < NQT; ++qt) {
                f32x4 z = (f32x4){-1e30f, -1e30f, -1e30f, -1e30f};
                if (!MF.skip(qt, t)) {
                    z = (f32x4){0.f, 0.f, 0.f, 0.f};
                    z = __builtin_amdgcn_mfma_f32_16x16x32_bf16(k0, qf[qt][0], z, 0, 0, 0);
                    z = __builtin_amdgcn_mfma_f32_16x16x32_bf16(k1, qf[qt][1], z, 0, 0, 0);
                    MF.apply(qt, t, z);
                }
                s[qt][t] = z;
            }
        }
    }
    __builtin_amdgcn_sched_barrier(0);
    u32x4 vr[NKT / 2][4];
#pragma unroll
    for (int kb = 0; kb < NKT / 2; ++kb)
#pragma unroll
        for (int i = 0; i < 4; ++i) vr[kb][i] = *(const u32x4*)(KF.vptr(2 * kb + (i >> 1)) + ((vrow + 8 * i) & 15) * 64 + vpart * 8);
    __builtin_amdgcn_sched_barrier(0);
#pragma unroll
    for (int qt = 0; qt < NQT; ++qt) {
        float m4[4] = {-1e30f, -1e30f, -1e30f, -1e30f};
#pragma unroll
        for (int t = 0; t < NKT; ++t) if (!MF.skip(qt, t)) {
#pragma unroll
            for (int e = 0; e < 4; ++e) m4[e] = fmaxf(m4[e], s[qt][t][e]);
        }
        float m = fmaxf(fmaxf(m4[0], m4[1]), fmaxf(m4[2], m4[3]));
        m = xmax16(m); m = xmax32(m);
        float s4[4] = {0.f, 0.f, 0.f, 0.f};
#pragma unroll
        for (int t = 0; t < NKT; ++t) {
            if (MF.skip(qt, t)) { s[qt][t] = (f32x4){0.f, 0.f, 0.f, 0.f}; continue; }
#pragma unroll
            for (int e = 0; e < 4; ++e) { const float p = fast_exp2(s[qt][t][e] - m); s[qt][t][e] = p; s4[e] += p; }
        }
        float sum = (s4[0] + s4[1]) + (s4[2] + s4[3]);
        sum = xsum16(sum); sum = xsum32(sum);
        mx[qt] = m; l[qt] = sum;
#pragma unroll
        for (int nd = 0; nd < 4; ++nd) o[qt][nd] = (f32x4){0.f, 0.f, 0.f, 0.f};
    }
    const int trow = (4 * fq + (fr >> 2)) * VROW + 8 * (fr & 3);
#pragma unroll
    for (int kb = 0; kb < NKT / 2; ++kb) {
#pragma unroll
        for (int i = 0; i < 4; ++i) *(LAS u32x4*)(vscr + (vrow + 8 * i) * VROW + vpart * 16) = vr[kb][i];
        bf16x8 pf[NQT];
#pragma unroll
        for (int qt = 0; qt < NQT; ++qt) {
            u32x4 w; w.x = cvt_pk_bf16(s[qt][2 * kb][0], s[qt][2 * kb][1]); w.y = cvt_pk_bf16(s[qt][2 * kb][2], s[qt][2 * kb][3]);
            w.z = cvt_pk_bf16(s[qt][2 * kb + 1][0], s[qt][2 * kb + 1][1]); w.w = cvt_pk_bf16(s[qt][2 * kb + 1][2], s[qt][2 * kb + 1][3]);
            pf[qt] = __builtin_bit_cast(bf16x8, w);
        }
#pragma unroll
        for (int nd = 0; nd < 4; ++nd) {
            const v4i16_t a0 = __builtin_amdgcn_ds_read_tr16_b64_v4i16((LAS v4i16_t*)(vscr + trow + 32 * nd));
            const v4i16_t a1 = __builtin_amdgcn_ds_read_tr16_b64_v4i16((LAS v4i16_t*)(vscr + trow + 16 * VROW + 32 * nd));
            bf16x8 vf; vf[0] = a0[0]; vf[1] = a0[1]; vf[2] = a0[2]; vf[3] = a0[3]; vf[4] = a1[0]; vf[5] = a1[1]; vf[6] = a1[2]; vf[7] = a1[3];
#pragma unroll
            for (int qt = 0; qt < NQT; ++qt) o[qt][nd] = __builtin_amdgcn_mfma_f32_16x16x32_bf16(vf, pf[qt], o[qt][nd], 0, 0, 0);
        }
    }
}

struct DilKF {
    const bf16_t* K; const bf16_t* V; int start0, n;
    __device__ __forceinline__ const bf16_t* kptr(int t) const { const int st = start0 + 16 * t; return K + (size_t)((st >= 0 && st < n) ? st : 0) * 64; }
    __device__ __forceinline__ const bf16_t* vptr(int t) const { const int st = start0 + 16 * t; return V + (size_t)((st >= 0 && st < n) ? st : 0) * 64; }
};
struct DilMF {
    int start0, n, fr, fq;
    __device__ __forceinline__ bool skip(int qt, int t) const { const int d = t - qt; return d <= -1 || d >= 9; }
    __device__ __forceinline__ void apply(int qt, int t, f32x4& z) const {
        const int st = start0 + 16 * t; const bool tv = (st >= 0 && st < n);
        const int d = t - qt;
        if (d >= 1 && d <= 7) {
#pragma unroll
            for (int e = 0; e < 4; ++e) z[e] = tv ? z[e] : -1e30f;
        } else {
            const int rel0 = 16 * t + 4 * fq - 64 - 16 * qt - fr;
#pragma unroll
            for (int e = 0; e < 4; ++e) { const int rel = rel0 + e; z[e] = (tv && rel >= -64 && rel <= 64) ? z[e] : -1e30f; }
        }
    }
};
struct NaKF {
    const bf16_t* K; const bf16_t* V; int row0;
    __device__ __forceinline__ const bf16_t* kptr(int t) const { return K + (size_t)(row0 + (t >> 1) * 64 + 16 * (t & 1)) * 64; }
    __device__ __forceinline__ const bf16_t* vptr(int t) const { return V + (size_t)(row0 + (t >> 1) * 64 + 16 * (t & 1)) * 64; }
};
struct NaMF {
    const LAS float* bp[2][4];
    __device__ __forceinline__ bool skip(int, int) const { return false; }
    __device__ __forceinline__ void apply(int qt, int t, f32x4& z) const {
#pragma unroll
        for (int e = 0; e < 4; ++e) z[e] += bp[t & 1][e][(t >> 1) * 31];
    }
};

__device__ __forceinline__ void gate_out_tile(LAS unsigned char* sc, int lane, const u32x4 (&gl)[2], const f32x4 (&v)[4], u32x4 (&outr)[2]) {
    const int fr = lane & 15, fq = lane >> 4, row = lane >> 3, part = lane & 7;
    *(LAS u32x4*)(sc + row * VROW + part * 16) = gl[0]; *(LAS u32x4*)(sc + (row + 8) * VROW + part * 16) = gl[1];
    u32x2 g[4], w[4];
#pragma unroll
    for (int nd = 0; nd < 4; ++nd) g[nd] = *(const LAS u32x2*)(sc + fr * VROW + 32 * nd + 8 * fq);
#pragma unroll
    for (int nd = 0; nd < 4; ++nd) { w[nd].x = cvt_pk_bf16(v[nd][0] * bf_lo(g[nd].x), v[nd][1] * bf_hi(g[nd].x)); w[nd].y = cvt_pk_bf16(v[nd][2] * bf_lo(g[nd].y), v[nd][3] * bf_hi(g[nd].y)); }
#pragma unroll
    for (int nd = 0; nd < 4; ++nd) *(LAS u32x2*)(sc + fr * VROW + 32 * nd + 8 * fq) = w[nd];
    outr[0] = *(const LAS u32x4*)(sc + row * VROW + part * 16); outr[1] = *(const LAS u32x4*)(sc + (row + 8) * VROW + part * 16);
}

__device__ __forceinline__ void h_row_finish(const Args& a, int m, int lane, const f32x4 (&v)[4]) {
    float s = 0.f;
#pragma unroll
    for (int j = 0; j < 4; ++j) s += (v[j].x * v[j].x + v[j].y * v[j].y) + (v[j].z * v[j].z + v[j].w * v[j].w);
    const float rstd = __builtin_amdgcn_rsqf(wave_sum(s) * (1.0f / DM) + 1e-6f);
    const f32x4* gp = (const f32x4*)a.in[2] + lane;
    u32x2* o8 = (u32x2*)((bf16_t*)(a.ws + WS_H) + (size_t)m * DM) + lane;
#pragma unroll
    for (int j = 0; j < 4; ++j) { const f32x4 g = gp[64 * j]; u32x2 w; w.x = cvt_pk_bf16(v[j].x * rstd * g.x, v[j].y * rstd * g.y); w.y = cvt_pk_bf16(v[j].z * rstd * g.z, v[j].w * rstd * g.w); o8[64 * j] = w; }
}

__device__ __forceinline__ void attn_phase(const Args& a, LAS unsigned char* lds, int lgL, int G, int hrow0) {
    const int tid = opaque_tid(), lane = tid & 63, wave = __builtin_amdgcn_readfirstlane(tid >> 6), fr = lane & 15, fq = lane >> 4;
    const int L = 1 << lgL;
    LAS float* biasl = (LAS float*)(lds + ATT_BIAS_OFF);
    for (int i = tid; i < 8 * 15 * 31; i += NTHREADS) biasl[i] = a.in[6][i] * LOG2E;
    if (tid < 256) ((LAS float*)(lds + ATT_NEG_OFF))[tid] = -1e30f;
    LAS unsigned char* vscr = lds + ATT_VSCR_OFF + wave * 5120;
    LAS bf16_t* ol = (LAS bf16_t*)(lds + ATT_O_OFF);
    LAS float* lsel = (LAS float*)(lds + ATT_LSE_OFF);
    __syncthreads();
    const int vb = (G % 8 == 0) ? (int)(blockIdx.x % 8) * (G / 8) + (int)(blockIdx.x / 8) : (int)blockIdx.x;
#ifndef ATT_DIL_REP
#define ATT_DIL_REP 1
#endif
#ifndef ATT_NA_REP
#define ATT_NA_REP 1
#endif
    const bool h_fused = (hrow0 >= 0) && (G == NHEAD * (RT / 512));
    const int hbase = hrow0 + ((int)blockIdx.x * NWAVES + wave) * 8;
    if (hrow0 >= 0) {
        for (int m = (int)blockIdx.x * NWAVES + wave; m < RT / 8 && !h_fused; m += G * NWAVES) {
#pragma unroll 1
            for (int q = 0; q < 8; ++q) { f32x4 v[4]; const f32x4* xr = (const f32x4*)x_row(a, hrow0 + m * 8 + q) + lane;
#pragma unroll
                for (int j = 0; j < 4; ++j) v[j] = xr[64 * j];
                h_row_finish(a, hrow0 + m * 8 + q, lane, v); }
        }
        if (h_fused) {
            f32x4 v[2][4];
#pragma unroll
            for (int q = 0; q < 2; ++q) { const f32x4* xr = (const f32x4*)x_row(a, hbase + 6 + q) + lane;
#pragma unroll
                for (int j = 0; j < 4; ++j) v[q][j] = xr[64 * j]; }
#pragma unroll
            for (int q = 0; q < 2; ++q) h_row_finish(a, hbase + 6 + q, lane, v[q]);
        }
    }
    for (int rep_ = 0; rep_ < ATT_DIL_REP; ++rep_)
    for (int unit = vb; unit < NHEAD * (RT / 512); unit += G) {
        const int head = unit >> 5, ml0 = (unit & 31) * 512, t0 = ml0 & (L - 1), sb = ml0 - t0;
#pragma unroll 1
        for (int g = 0; g < 3; ++g) {
            const int ld = 2 * g, n = L >> ld;
            const bf16_t* QG = (const bf16_t*)(a.ws + WS_HL + (size_t)(3 + 3 * g) * HL_BYTES) + (size_t)head * RT * 64;
            const bf16_t* KG = QG + HL_BYTES / 2; const bf16_t* VG = KG + HL_BYTES / 2;
#pragma unroll 1
            for (int kk = 0; kk < 2; ++kk) {
                const int k = 2 * wave + kk, sidx = k >> (4 - ld), p = k & ((16 >> ld) - 1);
                const int i0 = (t0 >> ld) + 32 * p, sub = sb + sidx * n;
                DilKF KF{KG + (size_t)sub * 64, VG + (size_t)sub * 64, i0 - 64, n};
                DilMF MF{i0 - 64, n, fr, fq};
                f32x4 hx[4];
                if (h_fused) { const f32x4* xr = (const f32x4*)x_row(a, hbase + 2 * g + kk) + lane;
#pragma unroll
                    for (int j = 0; j < 4; ++j) hx[j] = xr[64 * j]; }
                u32x4 gl[2][2];
                if (g == 2) {
#pragma unroll
                    for (int qt = 0; qt < 2; ++qt)
#pragma unroll
                        for (int i = 0; i < 2; ++i) {
                            const int tlr = sidx + ((32 * p + 16 * qt + (lane >> 3) + 8 * i) << ld);
                            gl[qt][i] = *(const u32x4*)((const bf16_t*)(a.ws + WS_SGB) + (size_t)(ml0 + tlr) * 512 + head * 64 + (lane & 7) * 8);
                        }
                }
                f32x4 o[2][4]; float mx[2], l[2];
                attn_core<2, 10, 10>(QG + (size_t)(sub + i0) * 64, KF, MF, vscr, lane, o, mx, l);
#pragma unroll
                for (int qt = 0; qt < 2; ++qt) {
                    const int tl = sidx + ((32 * p + 16 * qt + fr) << ld);
                    float lse = mx[qt] + __builtin_amdgcn_logf(l[qt]);
                    const float inv = __builtin_amdgcn_rcpf(l[qt]);
                    float wn = 1.0f, wo = 0.0f;
                    if (g > 0) {
                        const float lo_ = lsel[tl]; const float M = fmaxf(lo_, lse);
                        const float eo = fast_exp2(lo_ - M), en = fast_exp2(lse - M), sm = eo + en;
                        { const float rsm = __builtin_amdgcn_rcpf(sm); wo = eo * rsm; wn = en * rsm; } lse = M + __builtin_amdgcn_logf(sm);
                    }
                    f32x4 vv[4];
#pragma unroll
                    for (int nd = 0; nd < 4; ++nd) {
                        f32x4 v = o[qt][nd] * (inv * wn);
                        LAS u32x2* op = (LAS u32x2*)(ol + tl * 64 + 16 * nd + 4 * fq);
                        if (g > 0) { const u32x2 w = *op; v[0] += wo * bf_lo(w.x); v[1] += wo * bf_hi(w.x); v[2] += wo * bf_lo(w.y); v[3] += wo * bf_hi(w.y); }
                        if (g < 2) { u32x2 w; w.x = cvt_pk_bf16(v[0], v[1]); w.y = cvt_pk_bf16(v[2], v[3]); *op = w; }
                        vv[nd] = v;
                    }
                    if (g == 2) {
                        u32x4 outr[2];
                        gate_out_tile(vscr + qt * (16 * VROW), lane, gl[qt], vv, outr);
#pragma unroll
                        for (int i = 0; i < 2; ++i) {
                            const int tlr = sidx + ((32 * p + 16 * qt + (lane >> 3) + 8 * i) << ld);
                            *(u32x4*)((bf16_t*)(a.ws + WS_OA) + (size_t)(ml0 + tlr) * 1024 + 512 + head * 64 + (lane & 7) * 8) = outr[i];
                        }
                    }
                    if (g < 2 && fq == 0) lsel[tl] = lse;
                }
                if (h_fused) h_row_finish(a, hbase + 2 * g + kk, lane, hx);
            }
            asm volatile("s_waitcnt lgkmcnt(0)" ::: "memory"); __builtin_amdgcn_s_barrier(); asm volatile("" ::: "memory");
        }
    }
    {
        const bf16_t* QA0 = (const bf16_t*)(a.ws + WS_HL);
        const int rows = L >> 6;
#pragma unroll 1
        for (int rep_ = 0; rep_ < ATT_NA_REP; ++rep_)
#pragma unroll 1
        for (int task = vb * NWAVES + wave; task < NHEAD * (RT / 64) * 4; task += G * NWAVES) {
            const int nblk = task & 3, row64 = (task >> 2) & (RT / 64 - 1), head = task >> 10;
            const int ml0 = row64 * 64 + 16 * nblk, t = ml0 & (L - 1), sb = ml0 - t, r = t >> 6;
            int rs = r - 4; rs = rs < 0 ? 0 : (rs > rows - 8 ? rows - 8 : rs);
            int kb = 16 * nblk - 8; kb = kb < 0 ? 0 : (kb > 32 ? 32 : kb);
            const int qc = 16 * nblk + fr; int cst = qc - 8; cst = cst < 0 ? 0 : (cst > 48 ? 48 : cst);
            const bf16_t* QA = QA0 + (size_t)head * RT * 64; const bf16_t* KA = QA + HL_BYTES / 2; const bf16_t* VA = KA + HL_BYTES / 2;
            NaKF KF{KA, VA, sb + rs * 64 + kb};
            NaMF MF;
#pragma unroll
            for (int tb = 0; tb < 2; ++tb)
#pragma unroll
                for (int e = 0; e < 4; ++e) {
                    const int kc = kb + 16 * tb + 4 * fq + e; int dc = kc - qc; dc = dc < -15 ? -15 : (dc > 15 ? 15 : dc);
                    const bool ok = (kc >= cst && kc < cst + 16);
                    MF.bp[tb][e] = ok ? (biasl + (head * 15 + (rs - r + 7)) * 31 + dc + 15) : (const LAS float*)(lds + ATT_NEG_OFF);
                }
            u32x4 gl[2];
#pragma unroll
            for (int i = 0; i < 2; ++i) gl[i] = *(const u32x4*)((const bf16_t*)(a.ws + WS_SGA) + (size_t)(ml0 + (lane >> 3) + 8 * i) * 512 + head * 64 + (lane & 7) * 8);
            f32x4 o[1][4]; float mx[1], l[1];
            attn_core<1, 16, 16>(QA + (size_t)ml0 * 64, KF, MF, vscr, lane, o, mx, l);
            const float inv = __builtin_amdgcn_rcpf(l[0]);
            f32x4 vv[4]; u32x4 outr[2];
#pragma unroll
            for (int nd = 0; nd < 4; ++nd) vv[nd] = o[0][nd] * inv;
            gate_out_tile(vscr, lane, gl, vv, outr);
#pragma unroll
            for (int i = 0; i < 2; ++i) *(u32x4*)((bf16_t*)(a.ws + WS_OA) + (size_t)(ml0 + (lane >> 3) + 8 * i) * 1024 + head * 64 + (lane & 7) * 8) = outr[i];
        }
    }
    __syncthreads();
}

#define XB_TMO      128
#define XB_XCNT(j)  (256  + 64 * (j))
#define XB_XSUB(j)  (1280 + 64 * (j))
#define XB_XGEN(j)  (2304 + 64 * (j))
#define XB_TOP      3328
#define XB_TOPGEN   3392
#define XCD_BAR_WORDS 3456
#define XB_SPIN_CAP (1u << 18)

__device__ __forceinline__ unsigned xb_ld(unsigned* p)              { return __hip_atomic_load(p, __ATOMIC_RELAXED, __HIP_MEMORY_SCOPE_AGENT); }
__device__ __forceinline__ unsigned xb_add(unsigned* p, unsigned v) { return __hip_atomic_fetch_add(p, v, __ATOMIC_RELAXED, __HIP_MEMORY_SCOPE_AGENT); }
__device__ __forceinline__ unsigned xb_xcc_id() { return (unsigned)__builtin_amdgcn_s_getreg((3 << 11) | 20) & 0xFu; }
#define XB_SPIN(cond, bar) do { unsigned _sp = 0; while (cond) { __builtin_amdgcn_s_sleep(1); \
    if ((++_sp & 255u) == 0u) { if (xb_ld(&(bar)[XB_TMO])) break; if (_sp > XB_SPIN_CAP) { atomicAdd(&(bar)[XB_TMO], 1u); break; } } } } while (0)

struct XcdBarrier {
    unsigned* bar; unsigned x;
    volatile LAS unsigned* st;
};

__device__ __forceinline__ XcdBarrier xcd_barrier_post(unsigned* bar, volatile LAS unsigned* st) {
    XcdBarrier b; b.bar = bar; b.x = xb_xcc_id(); b.st = st;
    if (threadIdx.x == 0) (void)xb_add(&bar[XB_XCNT(b.x)], 1u);
    return b;
}
__device__ __forceinline__ void xcd_barrier_complete(unsigned* bar, unsigned x, unsigned& nloc, unsigned& nx) {
    const unsigned G = gridDim.x * gridDim.y * gridDim.z;
    unsigned sum, cnt, mine, sp = 0u;
    for (;;) {
        sum = 0u; cnt = 0u; mine = 0u;
#pragma unroll
        for (unsigned j = 0; j < 16; ++j) { const unsigned c = xb_ld(&bar[XB_XCNT(j)]); sum += c; cnt += (c > 0u) ? 1u : 0u; mine = (j == x) ? c : mine; }
        if (sum == G) break;
        __builtin_amdgcn_s_sleep(1);
        if ((++sp & 255u) == 0u) { if (xb_ld(&bar[XB_TMO])) break; if (sp > XB_SPIN_CAP) { atomicAdd(&bar[XB_TMO], 1u); break; } }
    }
    nloc = mine > 0u ? mine : 1u; nx = cnt > 0u ? cnt : 1u;
}

__device__ __forceinline__ void xcd_barrier(const XcdBarrier& b) {
    asm volatile("s_waitcnt vmcnt(0)" ::: "memory");
    __syncthreads();
    if (threadIdx.x == 0) {
        unsigned* bar = b.bar;
        __builtin_amdgcn_s_waitcnt(0);
        unsigned nloc = b.st[0], nx = b.st[1];
        if (nloc == 0u) { xcd_barrier_complete(bar, b.x, nloc, nx); b.st[0] = nloc; b.st[1] = nx; }
        const unsigned old = xb_add(&bar[XB_XSUB(b.x)], 1u);
        const unsigned gen = old / nloc;
        if (old + 1u == (gen + 1u) * nloc) {
            __builtin_amdgcn_fence(__ATOMIC_RELEASE, "agent");
            asm volatile("s_waitcnt vmcnt(0)" ::: "memory");
            const unsigned og = xb_add(&bar[XB_TOP], 1u);
            const unsigned tg = og / nx;
            if (og + 1u == (tg + 1u) * nx) xb_add(&bar[XB_TOPGEN], 1u);
            else XB_SPIN(xb_ld(&bar[XB_TOPGEN]) == tg, bar);
            __builtin_amdgcn_fence(__ATOMIC_ACQUIRE, "agent");
            xb_add(&bar[XB_XGEN(b.x)], 1u);
            asm volatile("s_waitcnt vmcnt(0)" ::: "memory");
        } else {
            XB_SPIN(xb_ld(&bar[XB_XGEN(b.x)]) == gen, bar);
            __builtin_amdgcn_fence(__ATOMIC_ACQUIRE, "agent");
            asm volatile("s_waitcnt vmcnt(0)" ::: "memory");
        }
    }
    __syncthreads();
}

constexpr int LDS_BYTES = 155648;
constexpr int N_PHASES = 3 + 2 * NROUND;

__global__ void __launch_bounds__(NTHREADS, 2) mk_fwd(Args args) {
    extern __shared__ __attribute__((aligned(16))) unsigned char lds_raw[];
    LAS unsigned char* lds = (LAS unsigned char*)lds_raw;
    const int G = gridDim.x;
    const int lo = args.ph_lo, hi = args.ph_hi;
    const bool coop = (hi - lo) > 1;
    volatile LAS unsigned* bar_st = (volatile LAS unsigned*)(lds + 131072);
    if (threadIdx.x < 2) bar_st[threadIdx.x] = 0u;
    __syncthreads();
    XcdBarrier bar; bar.bar = (unsigned*)(args.ws + WS_BAR); bar.x = 0; bar.st = bar_st;
    if (coop) bar = xcd_barrier_post((unsigned*)(args.ws + WS_BAR), bar_st);
    if (lo < 0) cg::this_grid().sync();
#ifndef PROBE_REPEAT
#define PROBE_REPEAT -1
#endif
    for (int ph2 = 2 * lo; ph2 < 2 * hi; ++ph2) {
        const int ph = ph2 >> 1;
        const int kind = ph == 0 ? 0 : (ph == 1 ? 1 : (ph == 2 ? 2 : 3 + ((ph - 3) & 1)));
        if ((ph2 & 1) && kind != PROBE_REPEAT) continue;
        if (kind == 0) {
            p0_prologue(args, lds, G);
        } else if (kind == 2) {
            attn_phase(args, lds, 12, G, RT);
        } else {
            const int r = kind == 1 ? -1 : (ph - 3) >> 1;
            const int rr = r + 1;
            const int rq = r < 0 ? 0 : r;
            SchedX S{(const char*)args.ws, WS_H + (size_t)(rr < NROUND ? rr : 0) * RT * DM * 2, kind == 1 ? 0 : kind - 2, kind == 4 ? 28 : 0,
                     rr >= NROUND ? 0 : (kind == 1 ? 36 : (kind == 3 ? 28 : 8)), G, (int)blockIdx.x};
            EpiX E{EpiG1{args.ws, rr < 2 ? 12 : 14, lds + EPI_LDS_OFF}, EpiG2{args.ws, lds + EPI_LDS_OFF}, EpiG3{x_row(args, rq * RT), args.out + (size_t)rq * RT * DM, lds + EPI_LDS_OFF}};
            const bool has_att = (kind == 4 && rr < NROUND);
            const bool att_first = has_att && (blockIdx.x & 1);
#pragma unroll 1
            for (int step = 0; step < 2; ++step) {
                if ((step == 0) != att_first) pg8::gemm_phase<1024>(lds, S, E);
                else if (has_att) attn_phase(args, lds, rr < 2 ? 12 : 14, G, rr + 1 < NROUND ? (rr + 1) * RT : -1);
            }
        }
        if (coop && ph2 + 1 < 2 * hi) { xcd_barrier(bar); }
    }
}

#ifndef MK_ONE_LAUNCH
#define MK_ONE_LAUNCH 1
#endif
extern "C" void kernel_launch(void* const* d_in, const int* in_sizes, int n_in, void* d_out, int out_size, void* d_ws, size_t ws_size, hipStream_t stream) {
    static int grid = 0;
    if (grid == 0) {
        if (n_in != 12 || ws_size < WS_END) { fprintf(stderr, "kernel_launch: unexpected n_in %d / ws %zu\n", n_in, ws_size); grid = -1; return; }
        int dev = 0, cus = 0, per_cu = 0;
        (void)hipGetDevice(&dev); (void)hipDeviceGetAttribute(&cus, hipDeviceAttributeMultiprocessorCount, dev);
        (void)hipFuncSetAttribute((const void*)mk_fwd, hipFuncAttributeMaxDynamicSharedMemorySize, LDS_BYTES);
        (void)hipOccupancyMaxActiveBlocksPerMultiprocessor(&per_cu, (const void*)mk_fwd, NTHREADS, LDS_BYTES);
        if (per_cu < 1) per_cu = 1;
        grid = cus * 1;
        (void)hipGetLastError();
    }
    if (grid < 0) return;
    Args a{};
    for (int i = 0; i < 12; ++i) a.in[i] = (const float*)d_in[i];
    a.out = (float*)d_out; a.ws = (unsigned char*)d_ws;
#if MK_ONE_LAUNCH
    (void)hipMemsetAsync((unsigned char*)d_ws + WS_BAR, 0, 16384, stream);
    a.ph_lo = 0; a.ph_hi = N_PHASES;
    void* kargs[] = {&a};
    hipError_t e = hipLaunchCooperativeKernel((const void*)mk_fwd, dim3(grid), dim3(NTHREADS), kargs, LDS_BYTES, stream);
    if (e != hipSuccess) fprintf(stderr, "cooperative launch failed: %s (grid %d)\n", hipGetErrorString(e), grid);
#else
    for (int p = 0; p < N_PHASES; ++p) {
        a.ph_lo = p; a.ph_hi = p + 1;
        hipLaunchKernelGGL(mk_fwd, dim3(grid), dim3(NTHREADS), LDS_BYTES, stream, a);
    }
#endif
}
```

```cpp
#include <hip/hip_runtime.h>
#include <hip/hip_cooperative_groups.h>
#include <cstdio>
#include <cstdint>
namespace cg = cooperative_groups;

#define LAS __attribute__((address_space(3)))
typedef unsigned short bf16_t;
typedef short bf16x8 __attribute__((ext_vector_type(8)));
typedef float f32x4 __attribute__((ext_vector_type(4)));
typedef float f32x2 __attribute__((ext_vector_type(2)));
typedef unsigned u32x4 __attribute__((ext_vector_type(4)));
typedef unsigned u32x2 __attribute__((ext_vector_type(2)));

constexpr int DM = 1024, DIN = 9216, T_ALL = 49152, RT = 16384, NROUND = 3, NHEAD = 8;
constexpr int NTHREADS = 512, NWAVES = 8;
constexpr float QSCALE = 0.125f * 1.4426950408889634f;
constexpr float LOG2E = 1.4426950408889634f;

constexpr size_t MiB = 1u << 20;
constexpr size_t WS_WIN = 0;
constexpr size_t WS_WA = 18 * MiB;
constexpr size_t WS_WB = 19 * MiB;
constexpr size_t WS_WO = 20 * MiB;
constexpr size_t WS_ROPE = 22 * MiB;
constexpr size_t WS_H = 26 * MiB;
constexpr size_t WS_HL = 122 * MiB;
constexpr size_t HL_BYTES = 16 * MiB;
constexpr size_t WS_SGA = WS_HL + 12 * HL_BYTES;
constexpr size_t WS_SGB = WS_SGA + 16 * MiB;
constexpr size_t WS_SMA = WS_SGB + 16 * MiB;
constexpr size_t WS_SMB = WS_SMA + 32 * MiB;
constexpr size_t WS_OA = WS_SMB + 32 * MiB;
constexpr size_t WS_OB = WS_OA + 16 * MiB;
constexpr size_t WS_GAINS = WS_OB + 16 * MiB;
constexpr size_t WS_BAR = WS_GAINS + 65536;
constexpr size_t WS_MERGED = WS_GAINS + 1 * MiB;
constexpr size_t WS_END = WS_MERGED + 32 * MiB;
constexpr size_t WS_P = WS_HL + 2 * HL_BYTES;
static_assert(WS_END <= 512 * MiB, "ws map");

__constant__ float INV_FREQ[32] = {1.000000000e+00f, 7.498942018e-01f, 5.623413324e-01f, 4.216965139e-01f, 3.162277639e-01f, 2.371373773e-01f, 1.778279394e-01f, 1.333521456e-01f, 1.000000015e-01f, 7.498942316e-02f, 5.623413250e-02f, 4.216964915e-02f, 3.162277490e-02f, 2.371373773e-02f, 1.778279431e-02f, 1.333521400e-02f, 9.999999776e-03f, 7.498942316e-03f, 5.623413250e-03f, 4.216964822e-03f, 3.162277630e-03f, 2.371373819e-03f, 1.778279431e-03f, 1.333521446e-03f, 1.000000047e-03f, 7.498941850e-04f, 5.623413017e-04f, 4.216965172e-04f, 3.162277571e-04f, 2.371373703e-04f, 1.778279402e-04f, 1.333521504e-04f};

typedef __bf16 bf16x2_hw __attribute__((ext_vector_type(2)));
__device__ __forceinline__ unsigned cvt_pk_bf16(float lo, float hi) { const f32x2 v = {lo, hi}; const bf16x2_hw b = __builtin_convertvector(v, bf16x2_hw); return __builtin_bit_cast(unsigned, b); }
__device__ __forceinline__ float bf_lo(unsigned u) { return __uint_as_float(u << 16); }
__device__ __forceinline__ float bf_hi(unsigned u) { return __uint_as_float(u & 0xffff0000u); }
__device__ __forceinline__ float bf2f(bf16_t u) { return __uint_as_float(((unsigned)u) << 16); }
__device__ __forceinline__ float fast_exp2(float x) { return __builtin_amdgcn_exp2f(x); }
__device__ __forceinline__ float sigmoidf_(float x) { return __builtin_amdgcn_rcpf(1.0f + __builtin_amdgcn_exp2f(x * -1.4426950408889634f)); }
__device__ __forceinline__ float xsum16(float x) { const auto r = __builtin_amdgcn_permlane16_swap(__float_as_uint(x), __float_as_uint(x), false, false); return __uint_as_float(r[0]) + __uint_as_float(r[1]); }
__device__ __forceinline__ float xsum32(float x) { const auto r = __builtin_amdgcn_permlane32_swap(__float_as_uint(x), __float_as_uint(x), false, false); return __uint_as_float(r[0]) + __uint_as_float(r[1]); }
__device__ __forceinline__ float xmax16(float x) { const auto r = __builtin_amdgcn_permlane16_swap(__float_as_uint(x), __float_as_uint(x), false, false); return fmaxf(__uint_as_float(r[0]), __uint_as_float(r[1])); }
__device__ __forceinline__ float xmax32(float x) { const auto r = __builtin_amdgcn_permlane32_swap(__float_as_uint(x), __float_as_uint(x), false, false); return fmaxf(__uint_as_float(r[0]), __uint_as_float(r[1])); }
__device__ __forceinline__ int opaque_tid() { int t = threadIdx.x; asm volatile("" : "+v"(t)); return t; }
__device__ __forceinline__ float wave_sum(float v) {
#pragma unroll
    for (int o = 1; o < 64; o <<= 1) v += __shfl_xor(v, o);
    return v;
}

namespace pg8 {
constexpr int BM = 256, BK = 64, HALF = 128, HTB = HALF * BK * 2, STAGE_BYTES = 8 * HTB, NXCD = 8, WGM = 8;
__host__ __device__ __forceinline__ int lds_byte(int r, int c) { const int st = (r >> 4) * 2 + (c >> 5), rr = r & 15, cc = c & 31, ob = rr * 64 + cc * 2; return st * 1024 + (ob ^ (((ob >> 9) & 1) << 5)); }
__host__ __device__ __forceinline__ void stage_rc(int b, int& R, int& C) { const int st = b / 1024, sb = b % 1024, swz = sb ^ (((sb >> 9) & 1) << 5); R = (st >> 1) * 16 + swz / 64; C = (st & 1) * 32 + (swz % 64) / 2; }
__host__ __device__ __forceinline__ int perm32(int rho) { const int n = rho >> 4, i = rho & 15; return 8 * (i >> 2) + 4 * n + (i & 3); }

struct Unit { int pm, pn, br; };

__device__ __forceinline__ void tile_of(int L, int nM, int nN, int& pm, int& pn) {
    const int nwg = nM * nN; int wgid = L;
    { const int q = nwg / NXCD, r = nwg % NXCD, xcd = wgid % NXCD, off = wgid / NXCD; wgid = (xcd < r ? xcd * (q + 1) : r * (q + 1) + (xcd - r) * q) + off; }
    const int nig = WGM * nN, gid = wgid / nig, fm = gid * WGM, gsz = (nM - fm) < WGM ? (nM - fm) : WGM;
    pm = fm + ((wgid % nig) % gsz); pn = (wgid % nig) / gsz;
}

template <int K, class Epi, class Sched>
__device__ __forceinline__ void gemm_phase(LAS unsigned char* lds, const Sched& S, const Epi& E) {
    int tid_ = threadIdx.x; asm volatile("" : "+v"(tid_));
    const int tid = tid_, wid = __builtin_amdgcn_readfirstlane(tid >> 6), lane = tid & 63, wr = wid >> 2, wc = wid & 3, fr = lane & 15, fq = lane >> 4;
    const int nt = K / BK;
    unsigned voffA[2], voffB[2];
#pragma unroll
    for (int i = 0; i < 2; ++i) { int R, C; stage_rc(tid * 16 + i * 8192, R, C); const int Rb = 64 * (R >> 5) + perm32(R & 31);
        voffA[i] = (unsigned)(R * K + C) * 2u; voffB[i] = (unsigned)(Rb * K + C) * 2u; }
    const size_t kstep = (size_t)(BK * 2);
    const size_t hstep = (size_t)HALF * K * 2;
    const size_t hstepB = (size_t)32 * K * 2;
    const unsigned ldsw = (unsigned)wid * 1024u;
    const int aoff = lds_byte(wr * 64 + fr, fq * 8), boff = lds_byte(wc * 32 + fr, fq * 8);
#define PG8_SA(b, h) (((b) * 2 + (h)) * HTB)
#define PG8_SB(b, h) ((4 + (b) * 2 + (h)) * HTB)
#define PG8_STAGE(bufoff, gbase, voff) do { _Pragma("unroll") for (int _i = 0; _i < 2; ++_i) \
        __builtin_amdgcn_global_load_lds((const unsigned*)((const char*)(gbase) + (voff)[_i]), (LAS unsigned*)(lds + (bufoff) + ldsw + _i * 8192), 16, 0, 0); } while (0)
#define PG8_LDA(dst, b, h) do { _Pragma("unroll") for (int m = 0; m < 4; ++m) _Pragma("unroll") for (int k = 0; k < 2; ++k) dst[m][k] = *(const LAS bf16x8*)(lds + PG8_SA(b, h) + aoff + m * 2048 + k * 1024); } while (0)
#define PG8_LDB(dst, b, h) do { _Pragma("unroll") for (int n = 0; n < 2; ++n) _Pragma("unroll") for (int k = 0; k < 2; ++k) dst[n][k] = *(const LAS bf16x8*)(lds + PG8_SB(b, h) + boff + n * 2048 + k * 1024); } while (0)
#define PG8_MMA(ai, bj, At, Bt) do { __builtin_amdgcn_s_setprio(1); _Pragma("unroll") for (int m = 0; m < 4; ++m) _Pragma("unroll") for (int n = 0; n < 2; ++n) _Pragma("unroll") for (int k = 0; k < 2; ++k) \
        acc[ai][bj][m][n] = __builtin_amdgcn_mfma_f32_16x16x32_bf16(Bt[n][k], At[m][k], acc[ai][bj][m][n], 0, 0, 0); __builtin_amdgcn_s_setprio(0); } while (0)
#define PG8_WAIT_V(n) asm volatile("s_waitcnt vmcnt(" #n ")" ::: "memory")
#define PG8_WAIT_L(n) asm volatile("s_waitcnt lgkmcnt(" #n ")" ::: "memory")
#define PG8_BAR __builtin_amdgcn_s_barrier()
#define PG8_SCHED __builtin_amdgcn_sched_barrier(0)
    Unit cur, nxt; int ui = 0;
    if (!S.next(0, cur)) return;
    f32x4 acc[2][2][4][2];
#pragma unroll
    for (int a = 0; a < 2; ++a)
#pragma unroll
        for (int b = 0; b < 2; ++b)
#pragma unroll
            for (int m = 0; m < 4; ++m)
#pragma unroll
                for (int n = 0; n < 2; ++n) acc[a][b][m][n] = (f32x4){0.f, 0.f, 0.f, 0.f};
    bf16x8 At[4][2], B0[2][2], B1[2][2];
    const char* cA = S.a_ptr(cur); const char* cB = S.b_ptr(cur);
    PG8_STAGE(PG8_SB(0, 0), cB, voffB); PG8_STAGE(PG8_SB(0, 1), cB + hstepB, voffB); PG8_STAGE(PG8_SA(0, 0), cA, voffA); PG8_STAGE(PG8_SA(0, 1), cA + hstep, voffA);
    if (wr == 1) PG8_BAR;
    PG8_WAIT_V(2); PG8_BAR;
    PG8_STAGE(PG8_SB(1, 0), cB + kstep, voffB); PG8_STAGE(PG8_SA(1, 0), cA + kstep, voffA); PG8_STAGE(PG8_SB(1, 1), cB + hstepB + kstep, voffB);
    PG8_WAIT_V(6); PG8_BAR;
    for (;;) {
        const bool has_next = S.next(ui + 1, nxt);
        const char* nA = has_next ? S.a_ptr(nxt) : cA; const char* nB = has_next ? S.b_ptr(nxt) : cB;
        for (int t = 0; t < nt; t += 2) {
            const bool last = (t == nt - 2);
            const char* a1 = cA + (size_t)(t + 1) * kstep;
            const char* a2 = last ? nA : cA + (size_t)(t + 2) * kstep; const char* b2 = last ? nB : cB + (size_t)(t + 2) * kstep;
            const char* a3 = a2 + kstep; const char* b3 = b2 + kstep;
            if constexpr (Epi::MIDK) { if (t == nt / 2) { int z_ = t - nt / 2; asm volatile("" : "+v"(z_)); E.mid(acc, cur, wr, wc, fr + z_, fq); } }
            PG8_LDB(B0, 0, 0); PG8_LDB(B1, 0, 1); PG8_SCHED; PG8_LDA(At, 0, 0); PG8_STAGE(PG8_SA(1, 1), a1 + hstep, voffA);
            PG8_WAIT_V(8); PG8_WAIT_L(0); PG8_BAR; PG8_MMA(0, 0, At, B0); PG8_MMA(0, 1, At, B1); PG8_BAR; PG8_SCHED;
            PG8_LDA(At, 0, 1); PG8_STAGE(PG8_SB(0, 0), b2, voffB); PG8_STAGE(PG8_SB(0, 1), b2 + hstepB, voffB); PG8_STAGE(PG8_SA(0, 0), a2, voffA);
            PG8_WAIT_V(8); PG8_WAIT_L(0); PG8_BAR; PG8_MMA(1, 0, At, B0); PG8_MMA(1, 1, At, B1); PG8_BAR; PG8_SCHED;
            PG8_LDB(B0, 1, 0); PG8_LDB(B1, 1, 1); PG8_SCHED; PG8_LDA(At, 1, 0); PG8_STAGE(PG8_SA(0, 1), a2 + hstep, voffA);
            PG8_WAIT_V(8); PG8_WAIT_L(0); PG8_BAR; PG8_MMA(0, 0, At, B0); PG8_MMA(0, 1, At, B1); PG8_BAR; PG8_SCHED;
            PG8_LDA(At, 1, 1); PG8_STAGE(PG8_SB(1, 0), b3, voffB); PG8_STAGE(PG8_SB(1, 1), b3 + hstepB, voffB); PG8_STAGE(PG8_SA(1, 0), a3, voffA);
            PG8_WAIT_V(8); PG8_WAIT_L(0); PG8_BAR; PG8_MMA(1, 0, At, B0); PG8_MMA(1, 1, At, B1); PG8_BAR; PG8_SCHED;
        }
        if (wr == 0) PG8_BAR;
        E.fin(acc, cur, wr, wc, fr, fq);
        if (!has_next) break;
#pragma unroll
        for (int a = 0; a < 2; ++a)
#pragma unroll
            for (int b = 0; b < 2; ++b)
#pragma unroll
                for (int m = 0; m < 4; ++m)
#pragma unroll
                    for (int n = 0; n < 2; ++n) acc[a][b][m][n] = (f32x4){0.f, 0.f, 0.f, 0.f};
        cur = nxt; cA = nA; cB = nB; ++ui;
        if (wr == 1) PG8_BAR;
    }
    PG8_WAIT_V(0);
    PG8_BAR;
#undef PG8_SA
#undef PG8_SB
#undef PG8_STAGE
#undef PG8_LDA
#undef PG8_LDB
#undef PG8_MMA
#undef PG8_WAIT_V
#undef PG8_WAIT_L
#undef PG8_BAR
#undef PG8_SCHED
}
}
using pg8::Unit;

__device__ __forceinline__ int perm_row(int ml, int lgL, int ld) {
    const int L = 1 << lgL, t = ml & (L - 1), sb = ml - t;
    return sb + ((t & ((1 << ld) - 1)) << (lgL - ld)) + (t >> ld);
}

constexpr int EPI_LDS_OFF = 131072 + 256, EPI_SLICE = 16 * 144;
__device__ __forceinline__ void epi_rows(LAS unsigned char* sl, int fr, int fq, const u32x4& w0, const u32x4& w1, u32x4& r0, u32x4& r1) {
    *(LAS u32x4*)(sl + fr * 144 + fq * 16) = w0; *(LAS u32x4*)(sl + fr * 144 + 64 + fq * 16) = w1;
    const int lane = fr + 16 * fq, row = lane >> 3, part = lane & 7;
    r0 = *(const LAS u32x4*)(sl + row * 144 + part * 16); r1 = *(const LAS u32x4*)(sl + (row + 8) * 144 + part * 16);
}

__device__ __forceinline__ void rows_to_lane(LAS unsigned char* sl, int lane, int fr, int a0, int a1, const u32x4& r0, const u32x4& r1, u32x4& p0, u32x4& p1) {
    const int row = lane >> 3, part = lane & 7;
    *(LAS u32x4*)(sl + row * 144 + part * 16) = r0; *(LAS u32x4*)(sl + (row + 8) * 144 + part * 16) = r1;
    p0 = *(const LAS u32x4*)(sl + fr * 144 + a0 * 16); p1 = *(const LAS u32x4*)(sl + fr * 144 + a1 * 16);
}
__device__ __forceinline__ void lane_to_rows(LAS unsigned char* sl, int lane, int fr, int a0, int a1, const u32x4& p0, const u32x4& p1, u32x4& r0, u32x4& r1) {
    const int row = lane >> 3, part = lane & 7;
    *(LAS u32x4*)(sl + fr * 144 + a0 * 16) = p0; *(LAS u32x4*)(sl + fr * 144 + a1 * 16) = p1;
    r0 = *(const LAS u32x4*)(sl + row * 144 + part * 16); r1 = *(const LAS u32x4*)(sl + (row + 8) * 144 + part * 16);
}

struct EpiG1 {
    static constexpr bool MIDK = false;
    unsigned char* ws; int lgL; LAS unsigned char* lds_epi;
    __device__ __forceinline__ void fin(const f32x4 (&acc)[2][2][4][2], const Unit& u, int wr, int wc, int fr, int fq) const {
        const int cb = u.pn >> 1, half = u.pn & 1;
        const int rowb = u.pm * 256 + wr * 64 + fr;
        LAS unsigned char* sl = lds_epi + (wr * 4 + wc) * EPI_SLICE;
        const int lane_ = fr + 16 * fq, srow = lane_ >> 3, spart = lane_ & 7, rowb0 = u.pm * 256 + wr * 64;
        if (cb == 3 || cb >= 13) {
            bf16_t* dst; int ld_, colb; bool sig;
            if (cb == 3) { dst = (bf16_t*)(ws + WS_SGA); ld_ = 512; colb = half * 256; sig = false; }
            else if (cb == 13) { dst = (bf16_t*)(ws + WS_SGB); ld_ = 512; colb = half * 256; sig = false; }
            else if (cb < 16) { dst = (bf16_t*)(ws + WS_SMA); ld_ = 1024; colb = (u.pn - 28) * 256; sig = true; }
            else { dst = (bf16_t*)(ws + WS_SMB); ld_ = 1024; colb = (u.pn - 32) * 256; sig = true; }
#pragma unroll
            for (int ai = 0; ai < 2; ++ai)
#pragma unroll
                for (int m = 0; m < 4; ++m) {
                    float x[16], t[16];
#pragma unroll
                    for (int bj = 0; bj < 2; ++bj)
#pragma unroll
                        for (int n = 0; n < 2; ++n)
#pragma unroll
                            for (int e = 0; e < 4; ++e) x[8 * bj + 4 * n + e] = acc[ai][bj][m][n][e];
#pragma unroll
                    for (int j = 0; j < 16; ++j) t[j] = x[j] * -1.4426950408889634f;
#pragma unroll
                    for (int j = 0; j < 16; ++j) t[j] = __builtin_amdgcn_exp2f(t[j]);
#pragma unroll
                    for (int j = 0; j < 16; ++j) t[j] = 1.0f + t[j];
#pragma unroll
                    for (int j = 0; j < 16; ++j) t[j] = __builtin_amdgcn_rcpf(t[j]);
                    if (!sig) {
#pragma unroll
                        for (int j = 0; j < 16; ++j) t[j] = x[j] * t[j];
                    }
                    u32x4 w[2], r0, r1;
#pragma unroll
                    for (int bj = 0; bj < 2; ++bj) { w[bj].x = cvt_pk_bf16(t[8 * bj + 0], t[8 * bj + 1]); w[bj].y = cvt_pk_bf16(t[8 * bj + 2], t[8 * bj + 3]); w[bj].z = cvt_pk_bf16(t[8 * bj + 4], t[8 * bj + 5]); w[bj].w = cvt_pk_bf16(t[8 * bj + 6], t[8 * bj + 7]); }
                    if (sig) {
                        bf16_t* gp = dst + ((((size_t)(u.pm * 4 + (colb >> 8)) * 8 + (wr * 4 + wc)) * 2 + ai) * 4 + m) * 1024 + lane_ * 8;
                        *(u32x4*)gp = w[0]; *(u32x4*)(gp + 512) = w[1];
                    } else {
                        epi_rows(sl, fr, fq, w[0], w[1], r0, r1);
                        bf16_t* rp0 = dst + (size_t)(rowb0 + ai * 128 + m * 16 + srow) * ld_ + colb + wc * 64 + spart * 8;
                        *(u32x4*)rp0 = r0; *(u32x4*)(rp0 + (size_t)8 * ld_) = r1;
                    }
                }
            return;
        }
        const int hl = cb < 3 ? cb : cb - 1;
        const int typ = cb < 3 ? cb : (cb - 4) % 3;
        const int grp = cb < 3 ? -1 : (cb - 4) / 3;
        const int ld = grp < 0 ? 0 : 2 * grp;
        const int head = 4 * half + wc;
        bf16_t* dst = (bf16_t*)(ws + WS_HL + (size_t)hl * HL_BYTES) + (size_t)head * RT * 64 + 8 * spart;
        float gn[2][8];
        if (typ < 2) {
            const float* g = (const float*)(ws + WS_GAINS) + ((grp < 0 ? 0 : 2) + typ) * 64;
            const float sc = typ == 0 ? QSCALE : 1.0f;
#pragma unroll
            for (int bj = 0; bj < 2; ++bj)
#pragma unroll
                for (int j = 0; j < 8; ++j) gn[bj][j] = g[32 * bj + 8 * fq + j] * sc;
        }
        const float* rope = (const float*)(ws + WS_ROPE);
        const int Lm = (1 << lgL) - 1;
#pragma unroll
        for (int ai = 0; ai < 2; ++ai)
#pragma unroll
            for (int m = 0; m < 4; ++m) {
                const int ml = rowb + ai * 128 + m * 16;
                float v[2][8];
#pragma unroll
                for (int bj = 0; bj < 2; ++bj)
#pragma unroll
                    for (int n = 0; n < 2; ++n)
#pragma unroll
                        for (int e = 0; e < 4; ++e) v[bj][4 * n + e] = acc[ai][bj][m][n][e];
                if (typ < 2) {
                    float ss = 0.f;
#pragma unroll
                    for (int bj = 0; bj < 2; ++bj)
#pragma unroll
                        for (int j = 0; j < 8; ++j) ss += v[bj][j] * v[bj][j];
                    ss = xsum16(ss); ss = xsum32(ss);
                    const float rs = __builtin_amdgcn_rsqf(ss * (1.0f / 64.0f) + 1e-6f);
#pragma unroll
                    for (int bj = 0; bj < 2; ++bj)
#pragma unroll
                        for (int j = 0; j < 8; ++j) v[bj][j] = v[bj][j] * rs * gn[bj][j];
                    if (grp >= 0) {
                        const float* rp = rope + (size_t)((ml & Lm) >> 4) * 1024 + (size_t)(fr + 16 * fq) * 4;
                        const f32x4 c0 = *(const f32x4*)(rp), c1 = *(const f32x4*)(rp + 256), s0 = *(const f32x4*)(rp + 512), s1 = *(const f32x4*)(rp + 768);
#pragma unroll
                        for (int j = 0; j < 8; ++j) {
                            const float c = j < 4 ? c0[j & 3] : c1[j & 3], s = j < 4 ? s0[j & 3] : s1[j & 3];
                            const float x1 = v[0][j], x2 = v[1][j];
                            v[0][j] = x1 * c - x2 * s; v[1][j] = x2 * c + x1 * s;
                        }
                    }
                }
                u32x4 w[2], r0, r1;
#pragma unroll
                for (int bj = 0; bj < 2; ++bj) { w[bj].x = cvt_pk_bf16(v[bj][0], v[bj][1]); w[bj].y = cvt_pk_bf16(v[bj][2], v[bj][3]); w[bj].z = cvt_pk_bf16(v[bj][4], v[bj][5]); w[bj].w = cvt_pk_bf16(v[bj][6], v[bj][7]); }
                epi_rows(sl, fr, fq, w[0], w[1], r0, r1);
                const int mls = rowb0 + ai * 128 + m * 16 + srow;
                *(u32x4*)(dst + (size_t)perm_row(mls, lgL, ld) * 64) = r0;
                *(u32x4*)(dst + (size_t)perm_row(mls + 8, lgL, ld) * 64) = r1;
                asm volatile("" ::: "memory");
            }
    }
};

struct EpiG2 {
    static constexpr bool MIDK = true;
    unsigned char* ws; LAS unsigned char* lds_epi;
    __device__ __forceinline__ void mid(f32x4 (&acc)[2][2][4][2], const Unit& u, int wr, int wc, int fr, int fq) const {
        const bf16_t* ga = (const bf16_t*)(ws + WS_SMA); const bf16_t* gb = (const bf16_t*)(ws + WS_SMB);
        const int frr = fr & 15, lane = frr + 16 * fq;
        const size_t base = ((size_t)(u.pm * 4 + u.pn) * 8 + (wr * 4 + wc)) * (2 * 4 * 1024) + (size_t)(lane + (fr - frr)) * 8;
#pragma unroll
        for (int ai = 0; ai < 2; ++ai) {
            u32x4 xa[4][2], xb[4][2];
#pragma unroll
            for (int m = 0; m < 4; ++m)
#pragma unroll
                for (int bj = 0; bj < 2; ++bj) { const size_t off = base + (size_t)((ai * 4 + m) * 2 + bj) * 512; xa[m][bj] = *(const u32x4*)(ga + off); xb[m][bj] = *(const u32x4*)(gb + off); }
#pragma unroll
            for (int m = 0; m < 4; ++m)
#pragma unroll
                for (int bj = 0; bj < 2; ++bj) {
                    const u32x4 x = xa[m][bj], y = xb[m][bj];
                    acc[ai][bj][m][0][0] *= bf_lo(x.x) * __builtin_amdgcn_rcpf(bf_lo(y.x)); acc[ai][bj][m][0][1] *= bf_hi(x.x) * __builtin_amdgcn_rcpf(bf_hi(y.x));
                    acc[ai][bj][m][0][2] *= bf_lo(x.y) * __builtin_amdgcn_rcpf(bf_lo(y.y)); acc[ai][bj][m][0][3] *= bf_hi(x.y) * __builtin_amdgcn_rcpf(bf_hi(y.y));
                    acc[ai][bj][m][1][0] *= bf_lo(x.z) * __builtin_amdgcn_rcpf(bf_lo(y.z)); acc[ai][bj][m][1][1] *= bf_hi(x.z) * __builtin_amdgcn_rcpf(bf_hi(y.z));
                    acc[ai][bj][m][1][2] *= bf_lo(x.w) * __builtin_amdgcn_rcpf(bf_lo(y.w)); acc[ai][bj][m][1][3] *= bf_hi(x.w) * __builtin_amdgcn_rcpf(bf_hi(y.w));
                }
            asm volatile("" ::: "memory");
        }
    }
    __device__ __forceinline__ void fin(const f32x4 (&acc)[2][2][4][2], const Unit& u, int wr, int wc, int fr, int fq) const {
        const bf16_t* gb = (const bf16_t*)(ws + WS_SMB); bf16_t* Mg = (bf16_t*)(ws + WS_MERGED);
        LAS unsigned char* sl = lds_epi + (wr * 4 + wc) * EPI_SLICE;
        const int lane = fr + 16 * fq, srow = lane >> 3, spart = lane & 7;
        const size_t base = (size_t)(u.pm * 256 + wr * 64 + srow) * 1024 + u.pn * 256 + wc * 64 + spart * 8;
        const size_t gbase = ((size_t)(u.pm * 4 + u.pn) * 8 + (wr * 4 + wc)) * (2 * 4 * 1024) + (size_t)lane * 8;
#pragma unroll
        for (int ai = 0; ai < 2; ++ai) {
            u32x4 rb[4][2];
#pragma unroll
            for (int m = 0; m < 4; ++m)
#pragma unroll
                for (int bj = 0; bj < 2; ++bj) rb[m][bj] = *(const u32x4*)(gb + gbase + (size_t)((ai * 4 + m) * 2 + bj) * 512);
#pragma unroll
            for (int m = 0; m < 4; ++m) {
                u32x4 w[2], r0, r1;
#pragma unroll
                for (int bj = 0; bj < 2; ++bj) {
                    const u32x4 y = rb[m][bj]; const f32x4 a0 = acc[ai][bj][m][0], a1 = acc[ai][bj][m][1];
                    w[bj].x = cvt_pk_bf16(a0[0] * bf_lo(y.x), a0[1] * bf_hi(y.x)); w[bj].y = cvt_pk_bf16(a0[2] * bf_lo(y.y), a0[3] * bf_hi(y.y));
                    w[bj].z = cvt_pk_bf16(a1[0] * bf_lo(y.z), a1[1] * bf_hi(y.z)); w[bj].w = cvt_pk_bf16(a1[2] * bf_lo(y.w), a1[3] * bf_hi(y.w));
                }
                lane_to_rows(sl, lane, fr, fq, 4 + fq, w[0], w[1], r0, r1);
                bf16_t* op = Mg + base + (size_t)(ai * 128 + m * 16) * 1024;
                *(u32x4*)op = r0; *(u32x4*)(op + 8 * 1024) = r1;
            }
            asm volatile("" ::: "memory");
        }
    }
};

struct EpiG3 {
    static constexpr bool MIDK = false;
    const float* x; float* out; LAS unsigned char* lds_epi;
    __device__ __forceinline__ void fin(const f32x4 (&acc)[2][2][4][2], const Unit& u, int wr, int wc, int fr, int fq) const {
        LAS unsigned char* sl = lds_epi + (wr * 4 + wc) * EPI_SLICE;
        const int lane = fr + 16 * fq, srow = lane >> 3, spart = lane & 7;
        const size_t base = (size_t)(u.pm * 256 + wr * 64 + srow) * 1024 + u.pn * 256 + wc * 64 + spart * 4;
#pragma unroll
        for (int ai = 0; ai < 2; ++ai)
#pragma unroll
            for (int mh = 0; mh < 2; ++mh) {
                u32x4 rx[2][2][2];
#pragma unroll
                for (int mm = 0; mm < 2; ++mm)
#pragma unroll
                    for (int bj = 0; bj < 2; ++bj)
#pragma unroll
                        for (int i = 0; i < 2; ++i) rx[mm][bj][i] = *(const u32x4*)(x + base + (size_t)(ai * 128 + (2 * mh + mm) * 16 + 8 * i) * 1024 + bj * 32);
#pragma unroll
                for (int mm = 0; mm < 2; ++mm)
#pragma unroll
                    for (int bj = 0; bj < 2; ++bj) {
                        const int m = 2 * mh + mm; u32x4 p0, p1, r0, r1;
                        rows_to_lane(sl, lane, fr, 2 * fq, 2 * fq + 1, rx[mm][bj][0], rx[mm][bj][1], p0, p1);
                        const f32x4 o0 = __builtin_bit_cast(f32x4, p0) + acc[ai][bj][m][0], o1 = __builtin_bit_cast(f32x4, p1) + acc[ai][bj][m][1];
                        lane_to_rows(sl, lane, fr, 2 * fq, 2 * fq + 1, __builtin_bit_cast(u32x4, o0), __builtin_bit_cast(u32x4, o1), r0, r1);
                        float* op = out + base + (size_t)(ai * 128 + m * 16) * 1024 + bj * 32;
                        *(u32x4*)op = r0; *(u32x4*)(op + 8 * 1024) = r1;
                    }
                asm volatile("" ::: "memory");
            }
    }
};

struct SchedX {
    const char* ws; size_t offH; int hk, pn_lo, n_pn, G, c;
    __device__ __forceinline__ bool next(int i, Unit& u) const {
        int L = i * G + c;
        if (hk > 0) {
            if (G == 256) {
                const int ng = (64 * n_pn) / 256, hp = (((c >> 3) & 7) * ng) / 7;
                if (i == hp) { pg8::tile_of(c, 64, 4, u.pm, u.pn); u.br = hk; return true; }
                const int j = i < hp ? i : i - 1;
                if (j >= ng) return false;
                L = j * 256 + c;
            } else {
                if (L < 256) { pg8::tile_of(L, 64, 4, u.pm, u.pn); u.br = hk; return true; }
                L -= 256;
            }
        }
        if (L >= 64 * n_pn) return false;
        int pnl; pg8::tile_of(L, 64, n_pn, u.pm, pnl);
        pnl += 4 * (((u.pm >> 3) * (n_pn >> 2)) >> 3); if (pnl >= n_pn) pnl -= n_pn;
        u.pn = pn_lo + pnl; u.br = 0; return true;
    }
    __device__ __forceinline__ const char* a_ptr(const Unit& u) const { const size_t off = u.br == 0 ? offH : (u.br == 1 ? WS_OA : WS_MERGED); return ws + off + (size_t)u.pm * (256 * 1024 * 2); }
    __device__ __forceinline__ const char* b_ptr(const Unit& u) const { const size_t off = u.br == 0 ? WS_WIN : (u.br == 1 ? WS_WA : WS_WO); return ws + off + (size_t)u.pn * (256 * 1024 * 2); }
};
struct EpiX {
    static constexpr bool MIDK = true;
    EpiG1 e1; EpiG2 e2; EpiG3 e3;
    __device__ __forceinline__ void mid(f32x4 (&acc)[2][2][4][2], const Unit& u, int wr, int wc, int fr, int fq) const { if (u.br == 1) e2.mid(acc, u, wr, wc, fr, fq); }
    __device__ __forceinline__ void fin(const f32x4 (&acc)[2][2][4][2], const Unit& u, int wr, int wc, int fr, int fq) const {
        if (u.br == 0) e1.fin(acc, u, wr, wc, fr, fq); else if (u.br == 1) e2.fin(acc, u, wr, wc, fr, fq); else e3.fin(acc, u, wr, wc, fr, fq);
    }
};

__device__ __forceinline__ void p0_transpose_item(const float* W, int K, int N, bf16_t* WT, int ldw, LAS float* scr, int item, int lane) {
    const int nblk = N / 32, kb = item / nblk, nb = item % nblk, k0 = 64 * kb, n0 = 32 * nb;
    float wv[32];
#pragma unroll
    for (int i = 0; i < 32; ++i) wv[i] = W[(size_t)(k0 + 2 * i + (lane >> 5)) * N + n0 + (lane & 31)];
#pragma unroll
    for (int i = 0; i < 32; ++i) scr[(2 * i + (lane >> 5)) * 33 + (lane & 31)] = wv[i];
    asm volatile("s_waitcnt lgkmcnt(0)" ::: "memory");
    const int c = lane & 7;
#pragma unroll
    for (int j = 0; j < 4; ++j) { const int n = (lane >> 3) + 8 * j; const LAS float* s = scr + (8 * c) * 33 + n;
        u32x4 o; o.x = cvt_pk_bf16(s[0 * 33], s[1 * 33]); o.y = cvt_pk_bf16(s[2 * 33], s[3 * 33]); o.z = cvt_pk_bf16(s[4 * 33], s[5 * 33]); o.w = cvt_pk_bf16(s[6 * 33], s[7 * 33]);
        *(u32x4*)(WT + (size_t)(n0 + n) * ldw + k0 + 8 * c) = o; }
    asm volatile("s_waitcnt lgkmcnt(0)" ::: "memory");
}

__device__ __forceinline__ void sincos_d(double x, float& s, float& c) {
    const double n = rint(x * 0.15915494309189535);
    double r = fma(-n, 6.283185307179586, x); r = fma(-n, 2.4492935982947064e-16, r);
    const double r2 = r * r;
    double ts = r, tc = 1.0, ss = r, cc = 1.0;
#pragma unroll
    for (int k = 1; k <= 14; ++k) {
        tc *= -r2 * (1.0 / (double)((2 * k - 1) * (2 * k))); cc += tc;
        ts *= -r2 * (1.0 / (double)((2 * k) * (2 * k + 1))); ss += ts;
    }
    s = (float)ss; c = (float)cc;
}

struct Args { const float* in[12]; float* out; unsigned char* ws; int ph_lo, ph_hi; };

__device__ __forceinline__ const float* x_row(const Args& a, int m) { return m < 32768 ? a.in[0] + (size_t)m * DM : a.in[1] + (size_t)(m - 32768) * DM; }

__device__ __forceinline__ void p0_prologue(const Args& a, LAS unsigned char* lds, int G) {
    const int tid = opaque_tid(), lane = tid & 63, wave = tid >> 6;
    LAS float* scr = (LAS float*)(lds + wave * 16384);
    const int gw = blockIdx.x * NWAVES + wave, NGW = G * NWAVES;
    constexpr int I_IN = 16 * 288, I_A = 8 * 32, I_O = 16 * 32;
    for (int it = gw; it < I_IN + 2 * I_A + I_O; it += NGW) {
        int r = it;
        if (r < I_IN) { p0_transpose_item(a.in[3], 1024, DIN, (bf16_t*)(a.ws + WS_WIN), 1024, scr, r, lane); continue; } r -= I_IN;
        if (r < I_A) { p0_transpose_item(a.in[9], 512, 1024, (bf16_t*)(a.ws + WS_WA), 1024, scr, r, lane); continue; } r -= I_A;
        if (r < I_A) { p0_transpose_item(a.in[10], 512, 1024, (bf16_t*)(a.ws + WS_WA) + 512, 1024, scr, r, lane); continue; } r -= I_A;
        p0_transpose_item(a.in[11], 1024, 1024, (bf16_t*)(a.ws + WS_WO), 1024, scr, r, lane);
    }
    if (blockIdx.x == 0 && tid < 64) {
        float* gt = (float*)(a.ws + WS_GAINS);
        gt[tid] = a.in[4][tid]; gt[64 + tid] = a.in[5][tid]; gt[128 + tid] = a.in[7][tid]; gt[192 + tid] = a.in[8][tid];
    }
    float* rope = (float*)(a.ws + WS_ROPE);
    for (int i = blockIdx.x * NTHREADS + tid; i < 16384 * 32; i += G * NTHREADS) {
        const int t = i >> 5, f = i & 31; const float ang = (float)t * INV_FREQ[f];
        float s, c; sincos_d((double)ang, s, c);
        { const size_t b = (size_t)(t >> 4) * 1024 + (size_t)(((f >> 2) & 1) * 256) + (size_t)((t & 15) + 16 * (f >> 3)) * 4 + (f & 3); rope[b] = c; rope[b + 512] = s; }
    }
    const float* gain = a.in[2];
    f32x4 gv[4];
#pragma unroll
    for (int j = 0; j < 4; ++j) gv[j] = *(const f32x4*)(gain + 4 * lane + 256 * j);
    bf16_t* H = (bf16_t*)(a.ws + WS_H);
    for (int m0 = gw * 8; m0 < RT; m0 += NGW * 8) {
        f32x4 v[8][4]; float s[8];
#pragma unroll
        for (int rr = 0; rr < 8; ++rr) { const f32x4* xr = (const f32x4*)x_row(a, m0 + rr) + lane;
#pragma unroll
            for (int j = 0; j < 4; ++j) v[rr][j] = xr[64 * j]; }
#pragma unroll
        for (int rr = 0; rr < 8; ++rr) { float t = 0.f;
#pragma unroll
            for (int j = 0; j < 4; ++j) t += (v[rr][j].x * v[rr][j].x + v[rr][j].y * v[rr][j].y) + (v[rr][j].z * v[rr][j].z + v[rr][j].w * v[rr][j].w);
            s[rr] = t; }
#pragma unroll
        for (int o = 1; o < 64; o <<= 1) {
#pragma unroll
            for (int rr = 0; rr < 8; ++rr) s[rr] += __shfl_xor(s[rr], o);
        }
#pragma unroll
        for (int rr = 0; rr < 8; ++rr) {
            const float rstd = 1.0f / sqrtf(s[rr] * (1.0f / DM) + 1e-6f);
            u32x2* o8 = (u32x2*)(H + (size_t)(m0 + rr) * DM) + lane;
#pragma unroll
            for (int j = 0; j < 4; ++j) { u32x2 w; w.x = cvt_pk_bf16(v[rr][j].x * rstd * gv[j].x, v[rr][j].y * rstd * gv[j].y); w.y = cvt_pk_bf16(v[rr][j].z * rstd * gv[j].z, v[rr][j].w * rstd * gv[j].w); o8[64 * j] = w; }
        }
    }
}

typedef short v4i16_t __attribute__((ext_vector_type(4)));
constexpr int ATT_O_OFF = 0;
constexpr int ATT_LSE_OFF = 65536;
constexpr int ATT_BIAS_OFF = 67584;
constexpr int ATT_NEG_OFF = 82464;
constexpr int ATT_VSCR_OFF = 83968;
constexpr int VROW = 160;

template <int NQT, int NKT, int KB, class KF_t, class MF_t>
__device__ __forceinline__ void attn_core(const bf16_t* qbase, const KF_t& KF, const MF_t& MF, LAS unsigned char* vscr, int lane,
                                          f32x4 (&o)[NQT][4], float (&mx)[NQT], float (&l)[NQT]) {
    const int fr = lane & 15, fq = lane >> 4;
    constexpr int NB = NKT / KB;
    const int vrow = (lane >> 3), vpart = lane & 7;
    bf16x8 qf[NQT][2];
    {
        u32x4 qr[NQT][2];
#pragma unroll
        for (int qt = 0; qt < NQT; ++qt)
#pragma unroll
            for (int i = 0; i < 2; ++i) qr[qt][i] = *(const u32x4*)(qbase + (size_t)(16 * qt + vrow + 8 * i) * 64 + vpart * 8);
#pragma unroll
        for (int qt = 0; qt < NQT; ++qt)
#pragma unroll
            for (int i = 0; i < 2; ++i) *(LAS u32x4*)(vscr + (16 * qt + vrow + 8 * i) * VROW + vpart * 16) = qr[qt][i];
#pragma unroll
        for (int qt = 0; qt < NQT; ++qt)
#pragma unroll
            for (int ks = 0; ks < 2; ++ks) qf[qt][ks] = *(const LAS bf16x8*)(vscr + (16 * qt + fr) * VROW + ks * 64 + fq * 16);
    }
    u32x4 kr[NKT / 2][4];
#pragma unroll
    for (int kb = 0; kb < NKT / 2; ++kb)
#pragma unroll
        for (int i = 0; i < 4; ++i) kr[kb][i] = *(const u32x4*)(KF.kptr(2 * kb + (i >> 1)) + ((vrow + 8 * i) & 15) * 64 + vpart * 8);
    __builtin_amdgcn_sched_barrier(0);
    f32x4 s[NQT][NKT];
#pragma unroll
    for (int kb = 0; kb < NKT / 2; ++kb) {
#pragma unroll
        for (int i = 0; i < 4; ++i) *(LAS u32x4*)(vscr + (vrow + 8 * i) * VROW + vpart * 16) = kr[kb][i];
#pragma unroll
        for (int tt = 0; tt < 2; ++tt) {
            const int t = 2 * kb + tt;
            const bf16x8 k0 = *(const LAS bf16x8*)(vscr + (16 * tt + fr) * VROW + fq * 16), k1 = *(const LAS bf16x8*)(vscr + (16 * tt + fr) * VROW + 64 + fq * 16);
#pragma unroll
            for (int qt = 0; qt < NQT; ++qt) {
                f32x4 z = (f32x4){-1e30f, -1e30f, -1e30f, -1e30f};
                if (!MF.skip(qt, t)) {
                    z = (f32x4){0.f, 0.f, 0.f, 0.f};
                    z = __builtin_amdgcn_mfma_f32_16x16x32_bf16(k0, qf[qt][0], z, 0, 0, 0);
                    z = __builtin_amdgcn_mfma_f32_16x16x32_bf16(k1, qf[qt][1], z, 0, 0, 0);
                    MF.apply(qt, t, z);
                }
                s[qt][t] = z;
            }
        }
    }
    __builtin_amdgcn_sched_barrier(0);
    u32x4 vr[NKT / 2][4];
#pragma unroll
    for (int kb = 0; kb < NKT / 2; ++kb)
#pragma unroll
        for (int i = 0; i < 4; ++i) vr[kb][i] = *(const u32x4*)(KF.vptr(2 * kb + (i >> 1)) + ((vrow + 8 * i) & 15) * 64 + vpart * 8);
    __builtin_amdgcn_sched_barrier(0);
#pragma unroll
    for (int qt = 0; qt < NQT; ++qt) {
        float m4[4] = {-1e30f, -1e30f, -1e30f, -1e30f};
#pragma unroll
        for (int t = 0; t < NKT; ++t) if (!MF.skip(qt, t)) {
#pragma unroll
            for (int e = 0; e < 4; ++e) m4[e] = fmaxf(m4[e], s[qt][t][e]);
        }
        float m = fmaxf(fmaxf(m4[0], m4[1]), fmaxf(m4[2], m4[3]));
        m = xmax16(m); m = xmax32(m);
        float s4[4] = {0.f, 0.f, 0.f, 0.f};
#pragma unroll
        for (int t = 0; t < NKT; ++t) {
            if (MF.skip(qt, t)) { s[qt][t] = (f32x4){0.f, 0.f, 0.f, 0.f}; continue; }
#pragma unroll
            for (int e = 0; e < 4; ++e) { const float p = fast_exp2(s[qt][t][e] - m); s[qt][t][e] = p; s4[e] += p; }
        }
        float sum = (s4[0] + s4[1]) + (s4[2] + s4[3]);
        sum = xsum16(sum); sum = xsum32(sum);
        mx[qt] = m; l[qt] = sum;
#pragma unroll
        for (int nd = 0; nd < 4; ++nd) o[qt][nd] = (f32x4){0.f, 0.f, 0.f, 0.f};
    }
    const int trow = (4 * fq + (fr >> 2)) * VROW + 8 * (fr & 3);
#pragma unroll
    for (int kb = 0; kb < NKT / 2; ++kb) {
#pragma unroll
        for (int i = 0; i < 4; ++i) *(LAS u32x4*)(vscr + (vrow + 8 * i) * VROW + vpart * 16) = vr[kb][i];
        bf16x8 pf[NQT];
#pragma unroll
        for (int qt = 0; qt < NQT; ++qt) {
            u32x4 w; w.x = cvt_pk_bf16(s[qt][2 * kb][0], s[qt][2 * kb][1]); w.y = cvt_pk_bf16(s[qt][2 * kb][2], s[qt][2 * kb][3]);
            w.z = cvt_pk_bf16(s[qt][2 * kb + 1][0], s[qt][2 * kb + 1][1]); w.w = cvt_pk_bf16(s[qt][2 * kb + 1][2], s[qt][2 * kb + 1][3]);
            pf[qt] = __builtin_bit_cast(bf16x8, w);
        }
#pragma unroll
        for (int nd = 0; nd < 4; ++nd) {
            const v4i16_t a0 = __builtin_amdgcn_ds_read_tr16_b64_v4i16((LAS v4i16_t*)(vscr + trow + 32 * nd));
            const v4i16_t a1 = __builtin_amdgcn_ds_read_tr16_b64_v4i16((LAS v4i16_t*)(vscr + trow + 16 * VROW + 32 * nd));
            bf16x8 vf; vf[0] = a0[0]; vf[1] = a0[1]; vf[2] = a0[2]; vf[3] = a0[3]; vf[4] = a1[0]; vf[5] = a1[1]; vf[6] = a1[2]; vf[7] = a1[3];
#pragma unroll
            for (int qt = 0; qt < NQT; ++qt) o[qt][nd] = __builtin_amdgcn_mfma_f32_16x16x32_bf16(vf, pf[qt], o[qt][nd], 0, 0, 0);
        }
    }
}

struct DilKF {
    const bf16_t* K; const bf16_t* V; int start0, n;
    __device__ __forceinline__ const bf16_t* kptr(int t) const { const int st = start0 + 16 * t; return K + (size_t)((st >= 0 && st < n) ? st : 0) * 64; }
    __device__ __forceinline__ const bf16_t* vptr(int t) const { const int st = start0 + 16 * t; return V + (size_t)((st >= 0 && st < n) ? st : 0) * 64; }
};
struct DilMF {
    int start0, n, fr, fq;
    __device__ __forceinline__ bool skip(int qt, int t) const { const int d = t - qt; return d <= -1 || d >= 9; }
    __device__ __forceinline__ void apply(int qt, int t, f32x4& z) const {
        const int st = start0 + 16 * t; const bool tv = (st >= 0 && st < n);
        const int d = t - qt;
        if (d >= 1 && d <= 7) {
#pragma unroll
            for (int e = 0; e < 4; ++e) z[e] = tv ? z[e] : -1e30f;
        } else {
            const int rel0 = 16 * t + 4 * fq - 64 - 16 * qt - fr;
#pragma unroll
            for (int e = 0; e < 4; ++e) { const int rel = rel0 + e; z[e] = (tv && rel >= -64 && rel <= 64) ? z[e] : -1e30f; }
        }
    }
};
struct NaKF {
    const bf16_t* K; const bf16_t* V; int row0;
    __device__ __forceinline__ const bf16_t* kptr(int t) const { return K + (size_t)(row0 + (t >> 1) * 64 + 16 * (t & 1)) * 64; }
    __device__ __forceinline__ const bf16_t* vptr(int t) const { return V + (size_t)(row0 + (t >> 1) * 64 + 16 * (t & 1)) * 64; }
};
struct NaMF {
    const LAS float* bp[2][4];
    __device__ __forceinline__ bool skip(int, int) const { return false; }
    __device__ __forceinline__ void apply(int qt, int t, f32x4& z) const {
#pragma unroll
        for (int e = 0; e < 4; ++e) z[e] += bp[t & 1][e][(t >> 1) * 31];
    }
};

__device__ __forceinline__ void gate_out_tile(LAS unsigned char* sc, int lane, const u32x4 (&gl)[2], const f32x4 (&v)[4], u32x4 (&outr)[2]) {
    const int fr = lane & 15, fq = lane >> 4, row = lane >> 3, part = lane & 7;
    *(LAS u32x4*)(sc + row * VROW + part * 16) = gl[0]; *(LAS u32x4*)(sc + (row + 8) * VROW + part * 16) = gl[1];
    u32x2 g[4], w[4];
#pragma unroll
    for (int nd = 0; nd < 4; ++nd) g[nd] = *(const LAS u32x2*)(sc + fr * VROW + 32 * nd + 8 * fq);
#pragma unroll
    for (int nd = 0; nd < 4; ++nd) { w[nd].x = cvt_pk_bf16(v[nd][0] * bf_lo(g[nd].x), v[nd][1] * bf_hi(g[nd].x)); w[nd].y = cvt_pk_bf16(v[nd][2] * bf_lo(g[nd].y), v[nd][3] * bf_hi(g[nd].y)); }
#pragma unroll
    for (int nd = 0; nd < 4; ++nd) *(LAS u32x2*)(sc + fr * VROW + 32 * nd + 8 * fq) = w[nd];
    outr[0] = *(const LAS u32x4*)(sc + row * VROW + part * 16); outr[1] = *(const LAS u32x4*)(sc + (row + 8) * VROW + part * 16);
}

__device__ __forceinline__ void h_row_finish(const Args& a, int m, int lane, const f32x4 (&v)[4]) {
    float s = 0.f;
#pragma unroll
    for (int j = 0; j < 4; ++j) s += (v[j].x * v[j].x + v[j].y * v[j].y) + (v[j].z * v[j].z + v[j].w * v[j].w);
    const float rstd = __builtin_amdgcn_rsqf(wave_sum(s) * (1.0f / DM) + 1e-6f);
    const f32x4* gp = (const f32x4*)a.in[2] + lane;
    u32x2* o8 = (u32x2*)((bf16_t*)(a.ws + WS_H) + (size_t)m * DM) + lane;
#pragma unroll
    for (int j = 0; j < 4; ++j) { const f32x4 g = gp[64 * j]; u32x2 w; w.x = cvt_pk_bf16(v[j].x * rstd * g.x, v[j].y * rstd * g.y); w.y = cvt_pk_bf16(v[j].z * rstd * g.z, v[j].w * rstd * g.w); o8[64 * j] = w; }
}

__device__ __forceinline__ void attn_phase(const Args& a, LAS unsigned char* lds, int lgL, int G, int hrow0) {
    const int tid = opaque_tid(), lane = tid & 63, wave = __builtin_amdgcn_readfirstlane(tid >> 6), fr = lane & 15, fq = lane >> 4;
    const int L = 1 << lgL;
    LAS float* biasl = (LAS float*)(lds + ATT_BIAS_OFF);
    for (int i = tid; i < 8 * 15 * 31; i += NTHREADS) biasl[i] = a.in[6][i] * LOG2E;
    if (tid < 256) ((LAS float*)(lds + ATT_NEG_OFF))[tid] = -1e30f;
    LAS unsigned char* vscr = lds + ATT_VSCR_OFF + wave * 5120;
    LAS bf16_t* ol = (LAS bf16_t*)(lds + ATT_O_OFF);
    LAS float* lsel = (LAS float*)(lds + ATT_LSE_OFF);
    __syncthreads();
    const int vb = (G % 8 == 0) ? (int)(blockIdx.x % 8) * (G / 8) + (int)(blockIdx.x / 8) : (int)blockIdx.x;
#ifndef ATT_DIL_REP
#define ATT_DIL_REP 1
#endif
#ifndef ATT_NA_REP
#define ATT_NA_REP 1
#endif
    const bool h_fused = (hrow0 >= 0) && (G == NHEAD * (RT / 512));
    const int hbase = hrow0 + ((int)blockIdx.x * NWAVES + wave) * 8;
    if (hrow0 >= 0) {
        for (int m = (int)blockIdx.x * NWAVES + wave; m < RT / 8 && !h_fused; m += G * NWAVES) {
#pragma unroll 1
            for (int q = 0; q < 8; ++q) { f32x4 v[4]; const f32x4* xr = (const f32x4*)x_row(a, hrow0 + m * 8 + q) + lane;
#pragma unroll
                for (int j = 0; j < 4; ++j) v[j] = xr[64 * j];
                h_row_finish(a, hrow0 + m * 8 + q, lane, v); }
        }
        if (h_fused) {
            f32x4 v[2][4];
#pragma unroll
            for (int q = 0; q < 2; ++q) { const f32x4* xr = (const f32x4*)x_row(a, hbase + 6 + q) + lane;
#pragma unroll
                for (int j = 0; j < 4; ++j) v[q][j] = xr[64 * j]; }
#pragma unroll
            for (int q = 0; q < 2; ++q) h_row_finish(a, hbase + 6 + q, lane, v[q]);
        }
    }
    for (int rep_ = 0; rep_ < ATT_DIL_REP; ++rep_)
    for (int unit = vb; unit < NHEAD * (RT / 512); unit += G) {
        const int head = unit >> 5, ml0 = (unit & 31) * 512, t0 = ml0 & (L - 1), sb = ml0 - t0;
#pragma unroll 1
        for (int g = 0; g < 3; ++g) {
            const int ld = 2 * g, n = L >> ld;
            const bf16_t* QG = (const bf16_t*)(a.ws + WS_HL + (size_t)(3 + 3 * g) * HL_BYTES) + (size_t)head * RT * 64;
            const bf16_t* KG = QG + HL_BYTES / 2; const bf16_t* VG = KG + HL_BYTES / 2;
#pragma unroll 1
            for (int kk = 0; kk < 2; ++kk) {
                const int k = 2 * wave + kk, sidx = k >> (4 - ld), p = k & ((16 >> ld) - 1);
                const int i0 = (t0 >> ld) + 32 * p, sub = sb + sidx * n;
                DilKF KF{KG + (size_t)sub * 64, VG + (size_t)sub * 64, i0 - 64, n};
                DilMF MF{i0 - 64, n, fr, fq};
                f32x4 hx[4];
                if (h_fused) { const f32x4* xr = (const f32x4*)x_row(a, hbase + 2 * g + kk) + lane;
#pragma unroll
                    for (int j = 0; j < 4; ++j) hx[j] = xr[64 * j]; }
                u32x4 gl[2][2];
                if (g == 2) {
#pragma unroll
                    for (int qt = 0; qt < 2; ++qt)
#pragma unroll
                        for (int i = 0; i < 2; ++i) {
                            const int tlr = sidx + ((32 * p + 16 * qt + (lane >> 3) + 8 * i) << ld);
                            gl[qt][i] = *(const u32x4*)((const bf16_t*)(a.ws + WS_SGB) + (size_t)(ml0 + tlr) * 512 + head * 64 + (lane & 7) * 8);
                        }
                }
                f32x4 o[2][4]; float mx[2], l[2];
                attn_core<2, 10, 10>(QG + (size_t)(sub + i0) * 64, KF, MF, vscr, lane, o, mx, l);
#pragma unroll
                for (int qt = 0; qt < 2; ++qt) {
                    const int tl = sidx + ((32 * p + 16 * qt + fr) << ld);
                    float lse = mx[qt] + __builtin_amdgcn_logf(l[qt]);
                    const float inv = __builtin_amdgcn_rcpf(l[qt]);
                    float wn = 1.0f, wo = 0.0f;
                    if (g > 0) {
                        const float lo_ = lsel[tl]; const float M = fmaxf(lo_, lse);
                        const float eo = fast_exp2(lo_ - M), en = fast_exp2(lse - M), sm = eo + en;
                        { const float rsm = __builtin_amdgcn_rcpf(sm); wo = eo * rsm; wn = en * rsm; } lse = M + __builtin_amdgcn_logf(sm);
                    }
                    f32x4 vv[4];
#pragma unroll
                    for (int nd = 0; nd < 4; ++nd) {
                        f32x4 v = o[qt][nd] * (inv * wn);
                        LAS u32x2* op = (LAS u32x2*)(ol + tl * 64 + 16 * nd + 4 * fq);
                        if (g > 0) { const u32x2 w = *op; v[0] += wo * bf_lo(w.x); v[1] += wo * bf_hi(w.x); v[2] += wo * bf_lo(w.y); v[3] += wo * bf_hi(w.y); }
                        if (g < 2) { u32x2 w; w.x = cvt_pk_bf16(v[0], v[1]); w.y = cvt_pk_bf16(v[2], v[3]); *op = w; }
                        vv[nd] = v;
                    }
                    if (g == 2) {
                        u32x4 outr[2];
                        gate_out_tile(vscr + qt * (16 * VROW), lane, gl[qt], vv, outr);
#pragma unroll
                        for (int i = 0; i < 2; ++i) {
                            const int tlr = sidx + ((32 * p + 16 * qt + (lane >> 3) + 8 * i) << ld);
                            *(u32x4*)((bf16_t*)(a.ws + WS_OA) + (size_t)(ml0 + tlr) * 1024 + 512 + head * 64 + (lane & 7) * 8) = outr[i];
                        }
                    }
                    if (g < 2 && fq == 0) lsel[tl] = lse;
                }
                if (h_fused) h_row_finish(a, hbase + 2 * g + kk, lane, hx);
            }
            asm volatile("s_waitcnt lgkmcnt(0)" ::: "memory"); __builtin_amdgcn_s_barrier(); asm volatile("" ::: "memory");
        }
    }
    {
        const bf16_t* QA0 = (const bf16_t*)(a.ws + WS_HL);
        const int rows = L >> 6;
#pragma unroll 1
        for (int rep_ = 0; rep_ < ATT_NA_REP; ++rep_)
#pragma unroll 1
        for (int task = vb * NWAVES + wave; task < NHEAD * (RT / 64) * 4; task += G * NWAVES) {
            const int nblk = task & 3, row64 = (task >> 2) & (RT / 64 - 1), head = task >> 10;
            const int ml0 = row64 * 64 + 16 * nblk, t = ml0 & (L - 1), sb = ml0 - t, r = t >> 6;
            int rs = r - 4; rs = rs < 0 ? 0 : (rs > rows - 8 ? rows - 8 : rs);
            int kb = 16 * nblk - 8; kb = kb < 0 ? 0 : (kb > 32 ? 32 : kb);
            const int qc = 16 * nblk + fr; int cst = qc - 8; cst = cst < 0 ? 0 : (cst > 48 ? 48 : cst);
            const bf16_t* QA = QA0 + (size_t)head * RT * 64; const bf16_t* KA = QA + HL_BYTES / 2; const bf16_t* VA = KA + HL_BYTES / 2;
            NaKF KF{KA, VA, sb + rs * 64 + kb};
            NaMF MF;
#pragma unroll
            for (int tb = 0; tb < 2; ++tb)
#pragma unroll
                for (int e = 0; e < 4; ++e) {
                    const int kc = kb + 16 * tb + 4 * fq + e; int dc = kc - qc; dc = dc < -15 ? -15 : (dc > 15 ? 15 : dc);
                    const bool ok = (kc >= cst && kc < cst + 16);
                    MF.bp[tb][e] = ok ? (biasl + (head * 15 + (rs - r + 7)) * 31 + dc + 15) : (const LAS float*)(lds + ATT_NEG_OFF);
                }
            u32x4 gl[2];
#pragma unroll
            for (int i = 0; i < 2; ++i) gl[i] = *(const u32x4*)((const bf16_t*)(a.ws + WS_SGA) + (size_t)(ml0 + (lane >> 3) + 8 * i) * 512 + head * 64 + (lane & 7) * 8);
            f32x4 o[1][4]; float mx[1], l[1];
            attn_core<1, 16, 16>(QA + (size_t)ml0 * 64, KF, MF, vscr, lane, o, mx, l);
            const float inv = __builtin_amdgcn_rcpf(l[0]);
            f32x4 vv[4]; u32x4 outr[2];
#pragma unroll
            for (int nd = 0; nd < 4; ++nd) vv[nd] = o[0][nd] * inv;
            gate_out_tile(vscr, lane, gl, vv, outr);
#pragma unroll
            for (int i = 0; i < 2; ++i) *(u32x4*)((bf16_t*)(a.ws + WS_OA) + (size_t)(ml0 + (lane >> 3) + 8 * i) * 1024 + head * 64 + (lane & 7) * 8) = outr[i];
        }
    }
    __syncthreads();
}

#define XB_TMO      128
#define XB_XCNT(j)  (256  + 64 * (j))
#define XB_XSUB(j)  (1280 + 64 * (j))
#define XB_XGEN(j)  (2304 + 64 * (j))
#define XB_TOP      3328
#define XB_TOPGEN   3392
#define XCD_BAR_WORDS 3456
#define XB_SPIN_CAP (1u << 18)

__device__ __forceinline__ unsigned xb_ld(unsigned* p)              { return __hip_atomic_load(p, __ATOMIC_RELAXED, __HIP_MEMORY_SCOPE_AGENT); }
__device__ __forceinline__ unsigned xb_add(unsigned* p, unsigned v) { return __hip_atomic_fetch_add(p, v, __ATOMIC_RELAXED, __HIP_MEMORY_SCOPE_AGENT); }
__device__ __forceinline__ unsigned xb_xcc_id() { return (unsigned)__builtin_amdgcn_s_getreg((3 << 11) | 20) & 0xFu; }
#define XB_SPIN(cond, bar) do { unsigned _sp = 0; while (cond) { __builtin_amdgcn_s_sleep(1); \
    if ((++_sp & 255u) == 0u) { if (xb_ld(&(bar)[XB_TMO])) break; if (_sp > XB_SPIN_CAP) { atomicAdd(&(bar)[XB_TMO], 1u); break; } } } } while (0)

struct XcdBarrier {
    unsigned* bar; unsigned x;
    volatile LAS unsigned* st;
};

__device__ __forceinline__ XcdBarrier xcd_barrier_post(unsigned* bar, volatile LAS unsigned* st) {
    XcdBarrier b; b.bar = bar; b.x = xb_xcc_id(); b.st = st;
    if (threadIdx.x == 0) (void)xb_add(&bar[XB_XCNT(b.x)], 1u);
    return b;
}
__device__ __forceinline__ void xcd_barrier_complete(unsigned* bar, unsigned x, unsigned& nloc, unsigned& nx) {
    const unsigned G = gridDim.x * gridDim.y * gridDim.z;
    unsigned sum, cnt, mine, sp = 0u;
    for (;;) {
        sum = 0u; cnt = 0u; mine = 0u;
#pragma unroll
        for (unsigned j = 0; j < 16; ++j) { const unsigned c = xb_ld(&bar[XB_XCNT(j)]); sum += c; cnt += (c > 0u) ? 1u : 0u; mine = (j == x) ? c : mine; }
        if (sum == G) break;
        __builtin_amdgcn_s_sleep(1);
        if ((++sp & 255u) == 0u) { if (xb_ld(&bar[XB_TMO])) break; if (sp > XB_SPIN_CAP) { atomicAdd(&bar[XB_TMO], 1u); break; } }
    }
    nloc = mine > 0u ? mine : 1u; nx = cnt > 0u ? cnt : 1u;
}

__device__ __forceinline__ void xcd_barrier(const XcdBarrier& b) {
    asm volatile("s_waitcnt vmcnt(0)" ::: "memory");
    __syncthreads();
    if (threadIdx.x == 0) {
        unsigned* bar = b.bar;
        __builtin_amdgcn_s_waitcnt(0);
        unsigned nloc = b.st[0], nx = b.st[1];
        if (nloc == 0u) { xcd_barrier_complete(bar, b.x, nloc, nx); b.st[0] = nloc; b.st[1] = nx; }
        const unsigned old = xb_add(&bar[XB_XSUB(b.x)], 1u);
        const unsigned gen = old / nloc;
        if (old + 1u == (gen + 1u) * nloc) {
            __builtin_amdgcn_fence(__ATOMIC_RELEASE, "agent");
            asm volatile("s_waitcnt vmcnt(0)" ::: "memory");
            const unsigned og = xb_add(&bar[XB_TOP], 1u);
            const unsigned tg = og / nx;
            if (og + 1u == (tg + 1u) * nx) xb_add(&bar[XB_TOPGEN], 1u);
            else XB_SPIN(xb_ld(&bar[XB_TOPGEN]) == tg, bar);
            __builtin_amdgcn_fence(__ATOMIC_ACQUIRE, "agent");
            xb_add(&bar[XB_XGEN(b.x)], 1u);
            asm volatile("s_waitcnt vmcnt(0)" ::: "memory");
        } else {
            XB_SPIN(xb_ld(&bar[XB_XGEN(b.x)]) == gen, bar);
            __builtin_amdgcn_fence(__ATOMIC_ACQUIRE, "agent");
            asm volatile("s_waitcnt vmcnt(0)" ::: "memory");
        }
    }
    __syncthreads();
}

constexpr int LDS_BYTES = 155648;
constexpr int N_PHASES = 3 + 2 * NROUND;

__global__ void __launch_bounds__(NTHREADS, 2) mk_fwd(Args args) {
    extern __shared__ __attribute__((aligned(16))) unsigned char lds_raw[];
    LAS unsigned char* lds = (LAS unsigned char*)lds_raw;
    const int G = gridDim.x;
    const int lo = args.ph_lo, hi = args.ph_hi;
    const bool coop = (hi - lo) > 1;
    volatile LAS unsigned* bar_st = (volatile LAS unsigned*)(lds + 131072);
    if (threadIdx.x < 2) bar_st[threadIdx.x] = 0u;
    __syncthreads();
    XcdBarrier bar; bar.bar = (unsigned*)(args.ws + WS_BAR); bar.x = 0; bar.st = bar_st;
    if (coop) bar = xcd_barrier_post((unsigned*)(args.ws + WS_BAR), bar_st);
    if (lo < 0) cg::this_grid().sync();
#ifndef PROBE_REPEAT
#define PROBE_REPEAT -1
#endif
    for (int ph2 = 2 * lo; ph2 < 2 * hi; ++ph2) {
        const int ph = ph2 >> 1;
        const int kind = ph == 0 ? 0 : (ph == 1 ? 1 : (ph == 2 ? 2 : 3 + ((ph - 3) & 1)));
        if ((ph2 & 1) && kind != PROBE_REPEAT) continue;
        if (kind == 0) {
            p0_prologue(args, lds, G);
        } else if (kind == 2) {
            attn_phase(args, lds, 12, G, RT);
        } else {
            const int r = kind == 1 ? -1 : (ph - 3) >> 1;
            const int rr = r + 1;
            const int rq = r < 0 ? 0 : r;
            SchedX S{(const char*)args.ws, WS_H + (size_t)(rr < NROUND ? rr : 0) * RT * DM * 2, kind == 1 ? 0 : kind - 2, kind == 4 ? 28 : 0,
                     rr >= NROUND ? 0 : (kind == 1 ? 36 : (kind == 3 ? 28 : 8)), G, (int)blockIdx.x};
            EpiX E{EpiG1{args.ws, rr < 2 ? 12 : 14, lds + EPI_LDS_OFF}, EpiG2{args.ws, lds + EPI_LDS_OFF}, EpiG3{x_row(args, rq * RT), args.out + (size_t)rq * RT * DM, lds + EPI_LDS_OFF}};
            const bool has_att = (kind == 4 && rr < NROUND);
            const bool att_first = has_att && (blockIdx.x & 1);
#pragma unroll 1
            for (int step = 0; step < 2; ++step) {
                if ((step == 0) != att_first) pg8::gemm_phase<1024>(lds, S, E);
                else if (has_att) attn_phase(args, lds, rr < 2 ? 12 : 14, G, rr + 1 < NROUND ? (rr + 1) * RT : -1);
            }
        }
        if (coop && ph + 1 < hi) { xcd_barrier(bar); }
    }
}

#ifndef MK_ONE_LAUNCH
#define MK_ONE_LAUNCH 1
#endif
extern "C" void kernel_launch(void* const* d_in, const int* in_sizes, int n_in, void* d_out, int out_size, void* d_ws, size_t ws_size, hipStream_t stream) {
    static int grid = 0;
    if (grid == 0) {
        if (n_in != 12 || ws_size < WS_END) { fprintf(stderr, "kernel_launch: unexpected n_in %d / ws %zu\n", n_in, ws_size); grid = -1; return; }
        int dev = 0, cus = 0, per_cu = 0;
        (void)hipGetDevice(&dev); (void)hipDeviceGetAttribute(&cus, hipDeviceAttributeMultiprocessorCount, dev);
        (void)hipFuncSetAttribute((const void*)mk_fwd, hipFuncAttributeMaxDynamicSharedMemorySize, LDS_BYTES);
        (void)hipOccupancyMaxActiveBlocksPerMultiprocessor(&per_cu, (const void*)mk_fwd, NTHREADS, LDS_BYTES);
        if (per_cu < 1) per_cu = 1;
        grid = cus * 1;
        (void)hipGetLastError();
    }
    if (grid < 0) return;
    Args a{};
    for (int i = 0; i < 12; ++i) a.in[i] = (const float*)d_in[i];
    a.out = (float*)d_out; a.ws = (unsigned char*)d_ws;
#if MK_ONE_LAUNCH
    (void)hipMemsetAsync((unsigned char*)d_ws + WS_BAR, 0, 16384, stream);
    a.ph_lo = 0; a.ph_hi = N_PHASES;
    void* kargs[] = {&a};
    hipError_t e = hipLaunchCooperativeKernel((const void*)mk_fwd, dim3(grid), dim3(NTHREADS), kargs, LDS_BYTES, stream);
    if (e != hipSuccess) fprintf(stderr, "cooperative launch failed: %s (grid %d)\n", hipGetErrorString(e), grid);
#else
    for (int p = 0; p < N_PHASES; ++p) {
        a.ph_lo = p; a.ph_hi = p + 1;
        hipLaunchKernelGGL(mk_fwd, dim3(grid), dim3(NTHREADS), LDS_BYTES, stream, a);
    }
#endif
}
```
